# Optimizing an MI355X kernel written in HIP

```python
import jax
import jax.numpy as jnp
from jax import lax
import numpy as np

D_MODEL = 1024
BATCH = 8
SEQ = 8192
DEPTH = 2

GRID_W = 64
CTX_LEN = 256
HEAD_DIM = 64
ATTN_SCALE = HEAD_DIM ** -0.5
ROPE_BASE = 10000.0
NORM_EPS = 1e-6
MASK_VALUE = -1e30
FFN_RES_W = 0.5
N_MOD = 9

N_GROUPS = 4
GROUP_WIDTH = D_MODEL // N_GROUPS
D_MIX = N_GROUPS * GROUP_WIDTH

GLA_DV = 64
GLA_HEADS = GROUP_WIDTH // GLA_DV
GLA_DK = GLA_DV // 2
GLA_GATE_RANK = 16
GLA_TAU = 16.0
GLA_CHUNK = 64

SWA_HEADS = GROUP_WIDTH // HEAD_DIM
SWA_KV_HEADS = SWA_HEADS // 2
SWA_WINDOW = 128
SWA_BLOCK = SWA_WINDOW

FA_HEADS = GROUP_WIDTH // HEAD_DIM
FA_KV_HEADS = FA_HEADS // 2
FA_BLOCK = 128

RWKV_HD = 64
RWKV_HEADS = GROUP_WIDTH // RWKV_HD
RWKV_DECAY_RANK = 32
RWKV_A_RANK = 32
RWKV_GATE_RANK = 64
RWKV_LN_EPS = 64e-5

D_FF = ((8 * D_MODEL // 3 + 127) // 128) * 128

GLA_SPLIT = (GLA_HEADS * GLA_DK, GLA_HEADS * GLA_DK, GLA_HEADS * GLA_DV, GLA_HEADS * GLA_DV, GLA_GATE_RANK, GLA_GATE_RANK)
SWA_SPLIT = (SWA_HEADS * HEAD_DIM, SWA_KV_HEADS * HEAD_DIM, SWA_KV_HEADS * HEAD_DIM)
FA_SPLIT = (FA_HEADS * HEAD_DIM, FA_KV_HEADS * HEAD_DIM, FA_KV_HEADS * HEAD_DIM)
RWKV_SPLIT = (GROUP_WIDTH, GROUP_WIDTH, GROUP_WIDTH, RWKV_DECAY_RANK, RWKV_DECAY_RANK, RWKV_A_RANK, RWKV_A_RANK, RWKV_GATE_RANK)
RWKV_IN = sum(RWKV_SPLIT)
GROUP_SPLIT = (sum(GLA_SPLIT), sum(SWA_SPLIT), sum(FA_SPLIT), RWKV_IN)
P_IN = sum(GROUP_SPLIT)

kernel_name = 'hybrid_parallel_group_dit_block'


def split_cols(p, widths):
    return jnp.split(p, np.cumsum(widths)[:-1].tolist(), axis=-1)


def rms_norm(x, g):
    xf = x.astype(jnp.float32)
    y = xf * lax.rsqrt(jnp.mean(xf * xf, axis=-1, keepdims=True) + NORM_EPS)
    return (y * g.astype(jnp.float32)).astype(x.dtype)


def modulate(h, shift, scale):
    return h * (1.0 + scale) + shift


def swiglu(h, w13, w2):
    a, b = jnp.split(h @ w13, 2, axis=-1)
    return (jax.nn.silu(a) * b) @ w2


def ffn_sublayer(x, shift, scale, gate, g_pre, g_post, w13, w2):
    y = swiglu(modulate(rms_norm(x, g_pre), shift, scale), w13, w2)
    return x + FFN_RES_W * gate * rms_norm(y, g_post)


def axial_rope_tables(n_rows):
    rows = jnp.repeat(jnp.arange(n_rows, dtype=jnp.float32), GRID_W)
    cols = jnp.tile(jnp.arange(GRID_W, dtype=jnp.float32), n_rows)
    half = HEAD_DIM // 2
    inv = ROPE_BASE ** (-jnp.arange(0, half, 2, dtype=jnp.float32) / half)
    ang_r = rows[:, None] * inv
    ang_c = cols[:, None] * inv
    ang = jnp.concatenate([ang_r, ang_r, ang_c, ang_c], axis=-1)
    return jnp.cos(ang), jnp.sin(ang)


def rotate_half(u):
    u1, u2 = jnp.split(u, 2, axis=-1)
    return jnp.concatenate([-u2, u1], axis=-1)


def apply_axial_rope(x, cos, sin):
    xr, xc = jnp.split(x, 2, axis=-1)
    rot = jnp.concatenate([rotate_half(xr), rotate_half(xc)], axis=-1)
    return (x * cos + rot * sin).astype(x.dtype)


def gqa_q(t, n_kv, g):
    B, T, _ = t.shape
    return t.reshape(B, T, n_kv, g, HEAD_DIM).transpose(0, 2, 3, 1, 4)


def kv_heads(t, n_kv):
    B, T, _ = t.shape
    return t.reshape(B, T, n_kv, HEAD_DIM).transpose(0, 2, 1, 3)


def merge_heads(o):
    B, K, G, T, d = o.shape
    return o.transpose(0, 3, 1, 2, 4).reshape(B, T, K * G * d)


def softmax_with_sink(logits, sink):
    ref = logits[0]
    K, G = ref.shape[1], ref.shape[2]
    s = jnp.broadcast_to(sink.astype(jnp.float32).reshape((1, K, G) + (1,) * (ref.ndim - 3)), ref.shape[:-1] + (1,))
    pr = jax.nn.softmax(jnp.concatenate(logits + [s], axis=-1), axis=-1)
    return pr[..., :-1]


def ctx_attention(q, k, v, sink):
    s = jnp.einsum('bkgqd,bktd->bkgqt', q, k).astype(jnp.float32) * ATTN_SCALE
    pr = softmax_with_sink([s], sink) if sink is not None else jax.nn.softmax(s, axis=-1)
    return merge_heads(jnp.einsum('bkgqt,bktd->bkgqd', pr.astype(v.dtype), v))


def gla_chunked(q, k, v, log_a, s0):
    B, H, T, dk = q.shape
    dv = v.shape[-1]
    C = GLA_CHUNK
    N = T // C
    q, k, log_a = (t.reshape(B, H, N, C, dk) for t in (q, k, log_a))
    v = v.reshape(B, H, N, C, dv)
    b = jnp.cumsum(log_a, axis=3)
    b_mid = b[:, :, :, C // 2 - 1:C // 2]
    b_last = b[:, :, :, C - 1:]
    tri = jnp.tril(jnp.ones((C, C), dtype=bool))
    attn = jnp.einsum('bhnid,bhnjd->bhnij', q * jnp.exp(b - b_mid), k * jnp.exp(b_mid - b))
    attn = jnp.where(tri, attn, 0.0)
    o = jnp.einsum('bhnij,bhnjv->bhniv', attn, v)
    kv = jnp.einsum('bhncd,bhncv->bhndv', k * jnp.exp(b_last - b), v)
    decay = jnp.exp(b_last[:, :, :, 0])

    def step(s, inp):
        kv_n, dec_n = inp
        return s * dec_n[..., None] + kv_n, s

    s_fin, s_prev = lax.scan(step, s0, (jnp.moveaxis(kv, 2, 0), jnp.moveaxis(decay, 2, 0)))
    o = o + jnp.einsum('bhncd,nbhdv->bhncv', q * jnp.exp(b), s_prev)
    return o.reshape(B, H, T, dv), s_fin


def gla_prep(p, wa2, ba):
    q, k, v, g, a_f, a_b = split_cols(p, GLA_SPLIT)
    B, T, _ = p.shape

    def heads(t, d):
        return t.astype(jnp.float32).reshape(B, T, GLA_HEADS, d).transpose(0, 2, 1, 3)

    q = heads(q, GLA_DK) * (GLA_DK ** -0.5)
    k = heads(k, GLA_DK)
    v = heads(v, GLA_DV)
    log_a = [heads(jax.nn.log_sigmoid((a_low @ wa2[d] + ba[d]).astype(jnp.float32)), GLA_DK) / GLA_TAU
             for d, a_low in enumerate((a_f, a_b))]
    return q, k, v, g, log_a


def gla_mixer(p_c, p_l, wa2, ba, onorm, need_ctx):
    qc, kc, vc, gc, lac = gla_prep(p_c, wa2, ba)
    ql, kl, vl, gl, lal = gla_prep(p_l, wa2, ba)
    s0 = jnp.zeros((p_l.shape[0], GLA_HEADS, GLA_DK, GLA_DV), jnp.float32)
    outs_l, outs_c = [], []
    for d in range(2):
        f = (lambda t: jnp.flip(t, axis=2)) if d == 1 else (lambda t: t)
        oc_d, s_ctx = gla_chunked(f(qc), f(kc), f(vc), f(lac[d]), s0)
        ol_d, _ = gla_chunked(f(ql), f(kl), f(vl), f(lal[d]), s_ctx)
        outs_l.append(f(ol_d))
        outs_c.append(f(oc_d))

    def finish(outs, g):
        o = rms_norm(outs[0] + outs[1], onorm)
        B, H, T, dv = o.shape
        o = o.transpose(0, 2, 1, 3).reshape(B, T, H * dv)
        return o.astype(g.dtype) * jax.nn.silu(g)

    return finish(outs_l, gl), (finish(outs_c, gc) if need_ctx else None)


def swa_mixer(p_c, p_l, sink, cos, sin, need_ctx):
    G = SWA_HEADS // SWA_KV_HEADS
    qc, kc, vc = split_cols(p_c, SWA_SPLIT)
    ql, kl, vl = split_cols(p_l, SWA_SPLIT)
    qc = gqa_q(qc, SWA_KV_HEADS, G)
    kc = kv_heads(kc, SWA_KV_HEADS)
    vc = kv_heads(vc, SWA_KV_HEADS)
    ql = apply_axial_rope(gqa_q(ql, SWA_KV_HEADS, G), cos, sin)
    kl = apply_axial_rope(kv_heads(kl, SWA_KV_HEADS), cos, sin)
    vl = kv_heads(vl, SWA_KV_HEADS)
    B, K, _, S, d = ql.shape
    nb = S // SWA_BLOCK
    qb = ql.reshape(B, K, G, nb, SWA_BLOCK, d)

    def band(t):
        tp = jnp.pad(t, ((0, 0), (0, 0), (SWA_WINDOW, SWA_WINDOW), (0, 0)))
        return jnp.concatenate([tp[:, :, j * SWA_BLOCK:j * SWA_BLOCK + S].reshape(B, K, nb, SWA_BLOCK, d)
                                for j in range(3)], axis=3)

    kb, vb = band(kl), band(vl)
    blk = jnp.arange(nb)[:, None]
    q_pos = blk * SWA_BLOCK + jnp.arange(SWA_BLOCK)[None, :]
    k_pos = blk * SWA_BLOCK - SWA_WINDOW + jnp.arange(3 * SWA_BLOCK)[None, :]
    kp = k_pos[:, None, :]
    valid = (jnp.abs(kp - q_pos[:, :, None]) <= SWA_WINDOW) & (kp >= 0) & (kp < S)
    s_win = jnp.einsum('bkgnqd,bknjd->bkgnqj', qb, kb).astype(jnp.float32) * ATTN_SCALE
    s_win = jnp.where(valid, s_win, MASK_VALUE)
    s_ctx = jnp.einsum('bkgnqd,bkcd->bkgnqc', qb, kc).astype(jnp.float32) * ATTN_SCALE
    pr = softmax_with_sink([s_win, s_ctx], sink)
    n_win = 3 * SWA_BLOCK
    o = (jnp.einsum('bkgnqj,bknjd->bkgnqd', pr[..., :n_win].astype(vb.dtype), vb)
         + jnp.einsum('bkgnqc,bkcd->bkgnqd', pr[..., n_win:].astype(vc.dtype), vc))
    o_l = merge_heads(o.reshape(B, K, G, S, d))
    o_c = ctx_attention(qc, kc, vc, sink) if need_ctx else None
    return o_l, o_c


def fa_mixer(p_c, p_l, q_g, k_g, cos, sin, need_ctx):
    G = FA_HEADS // FA_KV_HEADS

    def prep(p):
        q, k, v = split_cols(p, FA_SPLIT)
        return (rms_norm(gqa_q(q, FA_KV_HEADS, G), q_g), rms_norm(kv_heads(k, FA_KV_HEADS), k_g),
                kv_heads(v, FA_KV_HEADS))

    qc, kc, vc = prep(p_c)
    ql, kl, vl = prep(p_l)
    ql = apply_axial_rope(ql, cos, sin)
    kl = apply_axial_rope(kl, cos, sin)
    k_all = jnp.concatenate([kl, kc], axis=2)
    v_all = jnp.concatenate([vl, vc], axis=2)
    B, K, _, S, d = ql.shape
    nb = S // FA_BLOCK
    qb = ql.reshape(B, K, G, nb, FA_BLOCK, d).transpose(3, 0, 1, 2, 4, 5)

    def attend(q_blk):
        s = jnp.einsum('bkgqd,bktd->bkgqt', q_blk, k_all).astype(jnp.float32) * ATTN_SCALE
        pr = jax.nn.softmax(s, axis=-1).astype(v_all.dtype)
        return jnp.einsum('bkgqt,bktd->bkgqd', pr, v_all)

    o = lax.map(attend, qb)
    o_l = merge_heads(jnp.moveaxis(o, 0, 3).reshape(B, K, G, S, d))
    o_c = ctx_attention(qc, kc, vc, None) if need_ctx else None
    return o_l, o_c


def centred_shift_mix(p, mu_prev, mu_next):
    prev = jnp.pad(p, ((0, 0), (1, 0), (0, 0)))[:, :-1]
    nxt = jnp.pad(p, ((0, 0), (0, 1), (0, 0)))[:, 1:]
    return p + mu_prev * (prev - p) + mu_next * (nxt - p)


def rwkv7_scan(r, decay, k, v, kk, a, s0):
    def step(s, inp):
        r_t, w_t, k_t, v_t, kk_t, a_t = inp
        sa = jnp.einsum('bhvk,bhk->bhv', s, -kk_t)
        s = (s * w_t[:, :, None, :] + sa[..., None] * (kk_t * a_t)[:, :, None, :]
             + v_t[..., None] * k_t[:, :, None, :])
        return s, jnp.einsum('bhvk,bhk->bhv', s, r_t)

    s_fin, y = lax.scan(step, s0, tuple(jnp.moveaxis(t, 1, 0) for t in (r, decay, k, v, kk, a)))
    return jnp.moveaxis(y, 0, 1), s_fin


def rwkv_prep(p, mu, w0, w2, a0, a2, g2, k_k, k_a):
    p = centred_shift_mix(p, mu[0], mu[1])
    r, k, v, w_f, w_b, a_f, a_b, g1 = split_cols(p, RWKV_SPLIT)
    B, T, _ = p.shape

    def hv(t):
        return t.astype(jnp.float32).reshape(B, T, RWKV_HEADS, RWKV_HD)

    kk = hv(k * k_k)
    kk = kk * lax.rsqrt(jnp.maximum(jnp.sum(kk * kk, axis=-1, keepdims=True), 1e-24))
    g = jax.nn.sigmoid(g1) @ g2
    dirs = []
    for d, (w_low, a_low) in enumerate(((w_f, a_f), (w_b, a_b))):
        w = -jax.nn.softplus(-(w0[d] + jnp.tanh(w_low) @ w2[d]).astype(jnp.float32)) - 0.5
        decay = jnp.exp(-jnp.exp(w))
        a = jax.nn.sigmoid(a0[d] + a_low @ a2[d])
        k_d = k * (1.0 + (a - 1.0) * k_a)
        dirs.append((hv(decay), hv(k_d), hv(a)))
    return hv(r), hv(v), kk, g, dirs


def rwkv_mixer(p_c, p_l, mu, w0, w2, a0, a2, g2, k_k, k_a, r_k, ln_w, ln_b, need_ctx):
    rc, vc, kkc, gc, dc = rwkv_prep(p_c, mu, w0, w2, a0, a2, g2, k_k, k_a)
    rl, vl, kkl, gl, dl = rwkv_prep(p_l, mu, w0, w2, a0, a2, g2, k_k, k_a)
    s0 = jnp.zeros((p_l.shape[0], RWKV_HEADS, RWKV_HD, RWKV_HD), jnp.float32)
    ys_l, ys_c = [], []
    for d in range(2):
        f = (lambda t: jnp.flip(t, axis=1)) if d == 1 else (lambda t: t)
        dec_c, kd_c, a_c = dc[d]
        dec_l, kd_l, a_l = dl[d]
        yc_d, s_ctx = rwkv7_scan(f(rc), f(dec_c), f(kd_c), f(vc), f(kkc), f(a_c), s0)
        yl_d, _ = rwkv7_scan(f(rl), f(dec_l), f(kd_l), f(vl), f(kkl), f(a_l), s_ctx)
        ys_l.append(f(yl_d))
        ys_c.append(f(yc_d))
    lw = ln_w.reshape(RWKV_HEADS, RWKV_HD).astype(jnp.float32)
    lb = ln_b.reshape(RWKV_HEADS, RWKV_HD).astype(jnp.float32)
    rk = r_k.astype(jnp.float32)

    def finish(ys, r, v, dirs, g):
        y = ys[0] + ys[1]
        mean = jnp.mean(y, axis=-1, keepdims=True)
        var = jnp.mean(jnp.square(y - mean), axis=-1, keepdims=True)
        y = (y - mean) * lax.rsqrt(var + RWKV_LN_EPS) * lw + lb
        bonus = sum(jnp.sum(r * kd * rk, axis=-1, keepdims=True) * v for (_, kd, _) in dirs)
        B, T, H, N = y.shape
        return (y + bonus).reshape(B, T, H * N).astype(g.dtype) * g

    return finish(ys_l, rl, vl, dl, gl), (finish(ys_c, rc, vc, dc, gc) if need_ctx else None)


def setup_inputs(seed: int = 0) -> dict:
    key = jax.random.key(seed)
    ks = jax.random.split(key, 28)

    def nrm(k, shape, s):
        return jax.random.normal(k, shape, jnp.float32) * s

    L = DEPTH
    return {
        'x': nrm(ks[0], (BATCH, SEQ, D_MODEL), 1.0),
        'c': nrm(ks[1], (BATCH, D_MODEL), 1.0),
        'ctx': nrm(ks[2], (BATCH, CTX_LEN, D_MODEL), 1.0),
        'c_ctx': nrm(ks[3], (D_MODEL,), 1.0),
        'w_mod': nrm(ks[4], (L, D_MODEL, N_MOD * D_MODEL), D_MODEL ** -0.5),
        'b_mod': nrm(ks[5], (L, N_MOD * D_MODEL), 0.02),
        'norm_g': 1.0 + nrm(ks[6], (L, 6, D_MODEL), 0.02),
        'ffn_w13': nrm(ks[7], (L, 2, D_MODEL, 2 * D_FF), D_MODEL ** -0.5),
        'ffn_w2': nrm(ks[8], (L, 2, D_FF, D_MODEL), D_FF ** -0.5),
        'w_in': nrm(ks[9], (L, D_MODEL, P_IN), D_MODEL ** -0.5),
        'w_out': nrm(ks[10], (L, D_MIX, D_MODEL), D_MIX ** -0.5),
        'gla_wa2': nrm(ks[11], (L, 2, GLA_GATE_RANK, GLA_HEADS * GLA_DK), GLA_GATE_RANK ** -0.5),
        'gla_ba': nrm(ks[12], (L, 2, GLA_HEADS * GLA_DK), 0.1),
        'gla_onorm': 1.0 + nrm(ks[13], (L, GLA_DV), 0.02),
        'swa_sink': nrm(ks[14], (L, SWA_HEADS), 0.5),
        'fa_qnorm': 1.0 + nrm(ks[15], (L, HEAD_DIM), 0.02),
        'fa_knorm': 1.0 + nrm(ks[16], (L, HEAD_DIM), 0.02),
        'rw_mu': jax.random.uniform(ks[17], (L, 2, RWKV_IN), jnp.float32, 0.0, 0.5),
        'rw_w0': -0.5 + nrm(ks[18], (L, 2, GROUP_WIDTH), 0.5),
        'rw_w2': nrm(ks[19], (L, 2, RWKV_DECAY_RANK, GROUP_WIDTH), RWKV_DECAY_RANK ** -0.5),
        'rw_a0': nrm(ks[20], (L, 2, GROUP_WIDTH), 0.1),
        'rw_a2': nrm(ks[21], (L, 2, RWKV_A_RANK, GROUP_WIDTH), RWKV_A_RANK ** -0.5),
        'rw_g2': nrm(ks[22], (L, RWKV_GATE_RANK, GROUP_WIDTH), RWKV_GATE_RANK ** -0.5),
        'rw_kk': 1.0 + nrm(ks[23], (L, GROUP_WIDTH), 0.1),
        'rw_ka': 1.0 + nrm(ks[24], (L, GROUP_WIDTH), 0.1),
        'rw_rk': nrm(ks[25], (L, RWKV_HEADS, RWKV_HD), 0.1),
        'rw_lnw': 1.0 + nrm(ks[26], (L, GROUP_WIDTH), 0.02),
        'rw_lnb': nrm(ks[27], (L, GROUP_WIDTH), 0.02),
    }


def reference(x, c, ctx, c_ctx, w_mod, b_mod, norm_g, ffn_w13, ffn_w2, w_in, w_out,
              gla_wa2, gla_ba, gla_onorm, swa_sink, fa_qnorm, fa_knorm,
              rw_mu, rw_w0, rw_w2, rw_a0, rw_a2, rw_g2, rw_kk, rw_ka, rw_rk, rw_lnw, rw_lnb):
    n_rows = x.shape[1] // GRID_W
    cos, sin = axial_rope_tables(n_rows)
    xc = ctx
    for l in range(DEPTH):
        need_ctx = l < DEPTH - 1
        m_lat = (jax.nn.silu(c) @ w_mod[l] + b_mod[l])[:, None, :]
        m_ctx = jax.nn.silu(c_ctx) @ w_mod[l] + b_mod[l]
        m = [m_lat[..., i * D_MODEL:(i + 1) * D_MODEL] for i in range(N_MOD)]
        mc = [m_ctx[i * D_MODEL:(i + 1) * D_MODEL] for i in range(N_MOD)]
        g = norm_g[l]
        x = ffn_sublayer(x, m[0], m[1], m[2], g[0], g[1], ffn_w13[l, 0], ffn_w2[l, 0])
        xc = ffn_sublayer(xc, mc[0], mc[1], mc[2], g[0], g[1], ffn_w13[l, 0], ffn_w2[l, 0])
        h = modulate(rms_norm(x, g[2]), m[3], m[4])
        hc = modulate(rms_norm(xc, g[2]), mc[3], mc[4])
        p_gla, p_swa, p_fa, p_rw = split_cols(h @ w_in[l], GROUP_SPLIT)
        pc_gla, pc_swa, pc_fa, pc_rw = split_cols(hc @ w_in[l], GROUP_SPLIT)
        o_a, oc_a = gla_mixer(pc_gla, p_gla, gla_wa2[l], gla_ba[l], gla_onorm[l], need_ctx)
        o_b, oc_b = swa_mixer(pc_swa, p_swa, swa_sink[l], cos, sin, need_ctx)
        o_c, oc_c = fa_mixer(pc_fa, p_fa, fa_qnorm[l], fa_knorm[l], cos, sin, need_ctx)
        o_d, oc_d = rwkv_mixer(pc_rw, p_rw, rw_mu[l], rw_w0[l], rw_w2[l], rw_a0[l], rw_a2[l], rw_g2[l],
                               rw_kk[l], rw_ka[l], rw_rk[l], rw_lnw[l], rw_lnb[l], need_ctx)
        y = jnp.concatenate([o_a, o_b, o_c, o_d], axis=-1) @ w_out[l]
        x = x + m[5] * rms_norm(y, g[3])
        x = ffn_sublayer(x, m[6], m[7], m[8], g[4], g[5], ffn_w13[l, 1], ffn_w2[l, 1])
        if need_ctx:
            yc = jnp.concatenate([oc_a, oc_b, oc_c, oc_d], axis=-1) @ w_out[l]
            xc = xc + mc[5] * rms_norm(yc, g[3])
            xc = ffn_sublayer(xc, mc[6], mc[7], mc[8], g[4], g[5], ffn_w13[l, 1], ffn_w2[l, 1])
    return x
```

```cpp
#include <hip/hip_runtime.h>
#include <cstdio>
#include <cstdint>
#include <cmath>
namespace pg8 {
#define PG8_LAS __attribute__((address_space(3)))
typedef unsigned short bf16_t;
typedef short bf16x8 __attribute__((ext_vector_type(8)));
typedef float f32x4 __attribute__((ext_vector_type(4)));
typedef unsigned u32x4 __attribute__((ext_vector_type(4)));
constexpr int BM = 256, BK = 64, HALF = 128, HTB = HALF * BK * 2  , STAGE_BYTES = 8 * HTB, NXCD = 8, WGM = 8;

__host__ __device__ __forceinline__ int lds_byte(int r, int c) { const int st = (r >> 4) * 2 + (c >> 5), rr = r & 15, cc = c & 31, ob = rr * 64 + cc * 2; return st * 1024 + (ob ^ (((ob >> 9) & 1) << 5)); }
__host__ __device__ __forceinline__ void stage_rc(int b, int& R, int& C) { const int st = b / 1024, sb = b % 1024, swz = sb ^ (((sb >> 9) & 1) << 5); R = (st >> 1) * 16 + swz / 64; C = (st & 1) * 32 + (swz % 64) / 2; }
__host__ __device__ __forceinline__ int perm32(int rho) { const int n = rho >> 4, i = rho & 15; return 8 * (i >> 2) + 4 * n + (i & 3); }

struct Unit { int pm, pn; };
struct Gemm { const bf16_t* A; const bf16_t* Bt; int M, N, K; };

struct StaticOrder {
    int nM, nN, nwg, G, c, rev;
    __host__ __device__ void init(int M, int N, int G_, int c_, int rev_ = 0) { nM = M / BM; nN = N / BM; nwg = nM * nN; G = G_; c = c_; rev = rev_; }
    __host__ __device__ bool next(int i, Unit& u) const {
        const long L = (long)i * G + c; if (L >= nwg) return false;
        int wgid = (int)L; { const int q = nwg / NXCD, r = nwg % NXCD, xcd = wgid % NXCD, off = wgid / NXCD; wgid = (xcd < r ? xcd * (q + 1) : r * (q + 1) + (xcd - r) * q) + off; }
        const int nig = WGM * nN, gid = wgid / nig, fm = gid * WGM, gsz = (nM - fm) < WGM ? (nM - fm) : WGM;
        u.pm = fm + ((wgid % nig) % gsz); u.pn = (wgid % nig) / gsz; if (rev) { u.pm = nM - 1 - u.pm; u.pn = nN - 1 - u.pn; } return true;
    }
    __device__ __forceinline__ void a_ready(const Unit&) const {}
    __device__ __forceinline__ void done(const Unit&) const {}
};

__device__ __forceinline__ unsigned cvt_pk_bf16(float lo, float hi) { unsigned r; asm volatile("v_cvt_pk_bf16_f32 %0, %1, %2" : "=v"(r) : "v"(lo), "v"(hi)); return r; }
typedef float f32x2 __attribute__((ext_vector_type(2)));
__device__ __forceinline__ f32x2 gelu_pk(f32x2 v) {
    const f32x2 av = __builtin_elementwise_abs(v), d = av * 0.2316418882f + 1.0f;
    f32x2 t; t.x = __builtin_amdgcn_rcpf(d.x); t.y = __builtin_amdgcn_rcpf(d.y);
    f32x2 q = t * 0.5307027145f + (-0.7265760135f); q = q * t + 0.7107068705f; q = q * t + (-0.142248368f); q = q * t + 0.127414796f; q = q * t;
    const f32x2 s = (v * v) * (-0.72134752044f);
    f32x2 e; e.x = __builtin_amdgcn_exp2f(s.x); e.y = __builtin_amdgcn_exp2f(s.y);
    const f32x2 m = v * (q * e), r = v - m;
    f32x2 o; o.x = v.x < 0.f ? m.x : r.x; o.y = v.y < 0.f ? m.y : r.y; return o;
}

template <int ACT  > struct EpiBf16 {
    static constexpr bool PERM = true, AFTER_DRAIN = false; static_assert(ACT == 0 || ACT == 1, "EpiBf16: ACT is 0 (none) or 1 (gelu_pk)");
    bf16_t* O; int ldc; const float* bias; int split_cols; size_t split_stride; float scale0;
    __device__ __forceinline__ void operator()(const f32x4 (&acc)[2][2][4][2], const Unit& u, int wr, int wc, int fr, int fq) const {
        const int row0 = u.pm * BM + wr * 64 + fr; int colt = u.pn * BM; bf16_t* base = O;
        float sc = 1.f; if (split_cols) { const int t = colt / split_cols; base += (size_t)t * split_stride; colt -= t * split_cols; if (t == 0) sc = scale0; }
        const int col0 = colt + wc * 32 + 8 * fq, bcol0 = u.pn * BM + wc * 32 + 8 * fq;
        f32x4 bv[2][2];
#pragma unroll
        for (int bj = 0; bj < 2; ++bj)
#pragma unroll
            for (int n = 0; n < 2; ++n) bv[bj][n] = bias ? *(const f32x4*)(bias + bcol0 + bj * HALF + 4 * n) : (f32x4){0.f, 0.f, 0.f, 0.f};
#pragma unroll
        for (int ai = 0; ai < 2; ++ai)
#pragma unroll
            for (int m = 0; m < 4; ++m) { bf16_t* rowp = base + (size_t)(row0 + ai * HALF + m * 16) * ldc + col0;
#pragma unroll
                for (int bj = 0; bj < 2; ++bj) { f32x4 v0 = acc[ai][bj][m][0] + bv[bj][0], v1 = acc[ai][bj][m][1] + bv[bj][1];
                    if (ACT == 1) { f32x2 a = gelu_pk((f32x2){v0[0], v0[1]}), b = gelu_pk((f32x2){v0[2], v0[3]}), c = gelu_pk((f32x2){v1[0], v1[1]}), d = gelu_pk((f32x2){v1[2], v1[3]});
                        v0 = (f32x4){a.x, a.y, b.x, b.y}; v1 = (f32x4){c.x, c.y, d.x, d.y}; }
                    v0 = v0 * sc; v1 = v1 * sc; u32x4 w; w.x = cvt_pk_bf16(v0[0], v0[1]); w.y = cvt_pk_bf16(v0[2], v0[3]); w.z = cvt_pk_bf16(v1[0], v1[1]); w.w = cvt_pk_bf16(v1[2], v1[3]);
                    *(u32x4*)(rowp + bj * HALF) = w; } }
    }
};

struct EpiSwiglu {
    static constexpr bool PERM = true, AFTER_DRAIN = false;
    bf16_t* O; int ldc;
    __device__ __forceinline__ void operator()(const f32x4 (&acc)[2][2][4][2], const Unit& u, int wr, int wc, int fr, int fq) const {
        const int row0 = u.pm * BM + wr * 64 + fr; const int col0 = u.pn * HALF + wc * 32 + 8 * fq;
#pragma unroll
        for (int ai = 0; ai < 2; ++ai)
#pragma unroll
            for (int m = 0; m < 4; ++m) { bf16_t* rowp = O + (size_t)(row0 + ai * HALF + m * 16) * ldc + col0;
                float r[8];
#pragma unroll
                for (int n = 0; n < 2; ++n)
#pragma unroll
                    for (int e = 0; e < 4; ++e) { const float a = acc[ai][0][m][n][e], b = acc[ai][1][m][n][e];
                        const float sg = __builtin_amdgcn_rcpf(1.0f + __builtin_amdgcn_exp2f(-1.4426950408889634f * a)); r[n * 4 + e] = a * sg * b; }
                u32x4 w; w.x = cvt_pk_bf16(r[0], r[1]); w.y = cvt_pk_bf16(r[2], r[3]); w.z = cvt_pk_bf16(r[4], r[5]); w.w = cvt_pk_bf16(r[6], r[7]);
                *(u32x4*)rowp = w; }
    }
};
template <class Epi, class Sched, bool ALIGN_EPI = false, bool SP2 = false>
__device__ __forceinline__ void gemm_phase(PG8_LAS unsigned char* lds, const Gemm g, const Sched& S, const Epi& E) {
    int tid_; asm volatile("v_mov_b32 %0, %1" : "=v"(tid_) : "v"(threadIdx.x));
    const int tid = tid_, wid = __builtin_amdgcn_readfirstlane(tid >> 6), lane = tid & 63, wr = wid >> 2, wc = wid & 3, fr = lane & 15, fq = lane >> 4;
    const int K = g.K, nt = K / BK;
    unsigned voffA[2], voffB[2];
#pragma unroll
    for (int i = 0; i < 2; ++i) { int R, C; stage_rc(tid * 16 + i * 8192, R, C); const int Rb = Epi::PERM ? ((R & ~31) + perm32(R & 31)) : R;
        voffA[i] = (unsigned)(R * K + C) * 2u; voffB[i] = (unsigned)(Rb * K + C) * 2u; }
    const size_t kstep = (size_t)(BK * 2);
    const size_t hstep = (size_t)HALF * K * 2;
    const size_t tstep = 2 * hstep;
    const unsigned ldsw = (unsigned)wid * 1024u;
    const int aoff = lds_byte(wr * 64 + fr, fq * 8), boff = lds_byte(wc * 32 + fr, fq * 8);
#define PG8_SA(b, h) (((b) * 2 + (h)) * HTB)
#define PG8_SB(b, h) ((4 + (b) * 2 + (h)) * HTB)
#define PG8_STAGE(bufoff, gbase, voff) do { _Pragma("unroll") for (int _i = 0; _i < 2; ++_i) \
        __builtin_amdgcn_global_load_lds((const unsigned*)((const char*)(gbase) + (voff)[_i]), (PG8_LAS unsigned*)(lds + (bufoff) + ldsw + _i * 8192), 16, 0, 0); } while (0)
#define PG8_LDA(dst, b, h) do { _Pragma("unroll") for (int m = 0; m < 4; ++m) _Pragma("unroll") for (int k = 0; k < 2; ++k) dst[m][k] = *(const PG8_LAS bf16x8*)(lds + PG8_SA(b, h) + aoff + m * 2048 + k * 1024); } while (0)
#define PG8_LDB(dst, b, h) do { _Pragma("unroll") for (int n = 0; n < 2; ++n) _Pragma("unroll") for (int k = 0; k < 2; ++k) dst[n][k] = *(const PG8_LAS bf16x8*)(lds + PG8_SB(b, h) + boff + n * 2048 + k * 1024); } while (0)
#define PG8_MMA(ai, bj, At, Bt) do { __builtin_amdgcn_s_setprio(1); _Pragma("unroll") for (int m = 0; m < 4; ++m) _Pragma("unroll") for (int n = 0; n < 2; ++n) _Pragma("unroll") for (int k = 0; k < 2; ++k) \
        acc[ai][bj][m][n] = __builtin_amdgcn_mfma_f32_16x16x32_bf16(Bt[n][k], At[m][k], acc[ai][bj][m][n], 0, 0, 0); __builtin_amdgcn_s_setprio(0); } while (0)
#define PG8_WAIT_V(n) asm volatile("s_waitcnt vmcnt(" #n ")" ::: "memory")
#define PG8_WAIT_L(n) asm volatile("s_waitcnt lgkmcnt(" #n ")" ::: "memory")
#define PG8_BAR __builtin_amdgcn_s_barrier()
#define PG8_SCHED __builtin_amdgcn_sched_barrier(0)
    Unit cur, nxt; int ui = 0;
    if (!S.next(0, cur)) return;
    f32x4 acc[2][2][4][2];
#pragma unroll
    for (int a = 0; a < 2; ++a)
#pragma unroll
        for (int b = 0; b < 2; ++b)
#pragma unroll
            for (int m = 0; m < 4; ++m)
#pragma unroll
                for (int n = 0; n < 2; ++n) acc[a][b][m][n] = (f32x4){0.f, 0.f, 0.f, 0.f};
    bf16x8 At[4][2], B0[2][2], B1[2][2];
    const char* cA = (const char*)g.A + (size_t)cur.pm * tstep; const char* cB = (const char*)g.Bt + (size_t)cur.pn * tstep;
    S.a_ready(cur);
    if constexpr (SP2) {
        PG8_STAGE(PG8_SB(0, 0), cB, voffB); PG8_STAGE(PG8_SB(0, 1), cB + hstep, voffB); PG8_STAGE(PG8_SA(0, 0), cA, voffA); PG8_STAGE(PG8_SA(0, 1), cA + hstep, voffA);
        if (wr == 1) PG8_BAR;
        PG8_WAIT_V(2); PG8_BAR;
        PG8_STAGE(PG8_SB(1, 0), cB + kstep, voffB); PG8_STAGE(PG8_SA(1, 0), cA + kstep, voffA); PG8_STAGE(PG8_SB(1, 1), cB + hstep + kstep, voffB);
        PG8_WAIT_V(6); PG8_BAR;
    } else {
        PG8_STAGE(PG8_SB(0, 0), cB, voffB); PG8_STAGE(PG8_SA(0, 0), cA, voffA); PG8_STAGE(PG8_SB(0, 1), cB + hstep, voffB); PG8_STAGE(PG8_SA(0, 1), cA + hstep, voffA);
        if (wr == 1) PG8_BAR;
        PG8_WAIT_V(4); PG8_BAR;
        PG8_STAGE(PG8_SB(1, 0), cB + kstep, voffB); PG8_STAGE(PG8_SA(1, 0), cA + kstep, voffA); PG8_STAGE(PG8_SB(1, 1), cB + hstep + kstep, voffB);
        PG8_WAIT_V(6); PG8_BAR;
    }
    for (;;) {
        const bool has_next = S.next(ui + 1, nxt);
        const char* nA = has_next ? (const char*)g.A + (size_t)nxt.pm * tstep : cA; const char* nB = has_next ? (const char*)g.Bt + (size_t)nxt.pn * tstep : cB;
        for (int t = 0; t < nt; t += 2) {
            const bool last = (t == nt - 2);
            const char* a1 = cA + (size_t)(t + 1) * kstep;
            const char* a2 = last ? nA : cA + (size_t)(t + 2) * kstep; const char* b2 = last ? nB : cB + (size_t)(t + 2) * kstep;
            const char* a3 = a2 + kstep; const char* b3 = b2 + kstep;
            if (last && has_next) S.a_ready(nxt);
            if constexpr (SP2) {
            PG8_LDB(B0, 0, 0); PG8_LDB(B1, 0, 1); PG8_SCHED; PG8_LDA(At, 0, 0); PG8_STAGE(PG8_SA(1, 1), a1 + hstep, voffA);
            PG8_WAIT_V(8); PG8_WAIT_L(0); PG8_BAR; PG8_MMA(0, 0, At, B0); PG8_MMA(0, 1, At, B1); PG8_BAR; PG8_SCHED;
            PG8_LDA(At, 0, 1); PG8_STAGE(PG8_SB(0, 0), b2, voffB); PG8_STAGE(PG8_SB(0, 1), b2 + hstep, voffB); PG8_STAGE(PG8_SA(0, 0), a2, voffA);
            PG8_WAIT_V(8); PG8_WAIT_L(0); PG8_BAR; PG8_MMA(1, 0, At, B0); PG8_MMA(1, 1, At, B1); PG8_BAR; PG8_SCHED;
            PG8_LDB(B0, 1, 0); PG8_LDB(B1, 1, 1); PG8_SCHED; PG8_LDA(At, 1, 0); PG8_STAGE(PG8_SA(0, 1), a2 + hstep, voffA);
            PG8_WAIT_V(8); PG8_WAIT_L(0); PG8_BAR; PG8_MMA(0, 0, At, B0); PG8_MMA(0, 1, At, B1); PG8_BAR; PG8_SCHED;
            PG8_LDA(At, 1, 1); PG8_STAGE(PG8_SB(1, 0), b3, voffB); PG8_STAGE(PG8_SB(1, 1), b3 + hstep, voffB); PG8_STAGE(PG8_SA(1, 0), a3, voffA);
            PG8_WAIT_V(8); PG8_WAIT_L(0); PG8_BAR; PG8_MMA(1, 0, At, B0); PG8_MMA(1, 1, At, B1); PG8_BAR; PG8_SCHED;
            } else {
            PG8_LDB(B0, 0, 0); PG8_SCHED; PG8_LDA(At, 0, 0); PG8_STAGE(PG8_SA(1, 1), a1 + hstep, voffA);
            PG8_WAIT_L(8); PG8_BAR; PG8_WAIT_L(0); PG8_MMA(0, 0, At, B0); PG8_BAR; PG8_SCHED;
            PG8_LDB(B1, 0, 1); PG8_STAGE(PG8_SB(0, 0), b2, voffB);
            PG8_BAR; PG8_WAIT_L(0); PG8_MMA(0, 1, At, B1); PG8_BAR;
            PG8_LDA(At, 0, 1); PG8_STAGE(PG8_SA(0, 0), a2, voffA);
            PG8_BAR; PG8_WAIT_L(0); PG8_MMA(1, 0, At, B0); PG8_BAR; PG8_SCHED;
            PG8_STAGE(PG8_SB(0, 1), b2 + hstep, voffB);
            PG8_WAIT_V(6); PG8_BAR; PG8_MMA(1, 1, At, B1); PG8_BAR;
            PG8_LDB(B0, 1, 0); PG8_SCHED; PG8_LDA(At, 1, 0); PG8_STAGE(PG8_SA(0, 1), a2 + hstep, voffA);
            PG8_WAIT_L(8); PG8_BAR; PG8_WAIT_L(0); PG8_MMA(0, 0, At, B0); PG8_BAR; PG8_SCHED;
            PG8_LDB(B1, 1, 1); PG8_STAGE(PG8_SB(1, 0), b3, voffB);
            PG8_BAR; PG8_WAIT_L(0); PG8_MMA(0, 1, At, B1); PG8_BAR;
            PG8_LDA(At, 1, 1); PG8_STAGE(PG8_SA(1, 0), a3, voffA);
            PG8_BAR; PG8_WAIT_L(0); PG8_MMA(1, 0, At, B0); PG8_BAR; PG8_SCHED;
            PG8_STAGE(PG8_SB(1, 1), b3 + hstep, voffB);
            PG8_WAIT_V(6); PG8_BAR; PG8_MMA(1, 1, At, B1); PG8_BAR;
            }
        }
        if constexpr (ALIGN_EPI) { if (wr == 0) PG8_BAR; }
        if constexpr (!Epi::AFTER_DRAIN) { E(acc, cur, wr, wc, fr, fq); S.done(cur); }
        if (!has_next) break;
#pragma unroll
        for (int a = 0; a < 2; ++a)
#pragma unroll
            for (int b = 0; b < 2; ++b)
#pragma unroll
                for (int m = 0; m < 4; ++m)
#pragma unroll
                    for (int n = 0; n < 2; ++n) acc[a][b][m][n] = (f32x4){0.f, 0.f, 0.f, 0.f};
        cur = nxt; cA = nA; cB = nB; ++ui;
        if constexpr (ALIGN_EPI) { if (wr == 1) PG8_BAR; }
    }
    PG8_WAIT_V(0);
    if constexpr (!ALIGN_EPI) { if (wr == 0) PG8_BAR; }
    PG8_BAR;
    if constexpr (Epi::AFTER_DRAIN) { E.fused(acc, cur, wr, wc, fr, fq, lds, wid, lane); S.done(cur); }
#undef PG8_SA
#undef PG8_SB
#undef PG8_STAGE
#undef PG8_LDA
#undef PG8_LDB
#undef PG8_MMA
#undef PG8_WAIT_V
#undef PG8_WAIT_L
#undef PG8_BAR
#undef PG8_SCHED
}
}
#ifndef ATT_QPREP
#define ATT_QPREP 1
#endif
#ifndef ATT_VTR
#define ATT_VTR 0
#endif
constexpr int NWAVES = 8, NTHREADS = 512;
constexpr int DM = 1024, NB = 8, SEQ = 8192, CTXL = 256, NLAYER = 2, DFF = 2816, NMOD = 9;
constexpr int M_LAT = NB * SEQ, M_CTX = NB * CTXL, M_ALL = M_LAT + M_CTX;
constexpr int NKEY = SEQ + CTXL;
constexpr int NCHUNK = NKEY / 64;
constexpr int PIN = 2784, PW = 2816;
constexpr float NORM_EPS = 1e-6f, LOG2E = 1.4426950408889634f;
constexpr int NTILE64 = M_ALL / 64;

constexpr size_t MiB = 1u << 20;
constexpr size_t WS_CTL = 0, CTL_ZERO_BYTES = 1 * MiB;
constexpr size_t WS_MODV = 1 * MiB;
constexpr size_t WS_ROPE = 1 * MiB + 768 * 1024;
constexpr size_t WS_RWWT = 1 * MiB + 800 * 1024;
constexpr size_t WS_W13 = 2 * MiB;
constexpr size_t WS_W2 = 46 * MiB;
constexpr size_t WS_WIN = 68 * MiB;
constexpr size_t WS_WOUT = 79 * MiB;
constexpr size_t WS_XC = 84 * MiB;
constexpr size_t WS_KC = 92 * MiB;
constexpr size_t WS_VT = 125 * MiB;
constexpr size_t WS_GLAS = 158 * MiB;
constexpr size_t WS_HO = 228 * MiB;
constexpr size_t WS_Y = 360 * MiB;
constexpr size_t WS_UP = 492 * MiB;
constexpr size_t WS_RW = 855 * MiB;
constexpr size_t WS_END = 1024 * MiB;
constexpr size_t SZ_ROWS256 = (size_t)M_ALL * 256 * 2;
static_assert(WS_ROPE + 192 * 16 * 2 * 4 <= WS_RWWT && WS_RWWT + 2 * 49152 * 2 <= WS_W13, "ws map 0");
static_assert(WS_W13 + (size_t)4 * 5632 * 1024 * 2 <= WS_W2 && WS_W2 + (size_t)4 * 1024 * 2816 * 2 <= WS_WIN && WS_WIN + (size_t)2 * 2816 * 1024 * 2 <= WS_WOUT && WS_WOUT + (size_t)2 * 1024 * 1024 * 2 <= WS_XC, "ws map 1");
static_assert(WS_XC + (size_t)M_CTX * 1024 * 4 <= WS_KC && WS_KC + (size_t)NB * 4 * NKEY * 64 * 2 <= WS_VT && WS_VT + (size_t)NB * 4 * NKEY * 64 * 2 <= WS_GLAS, "ws map 2");
static_assert(WS_GLAS + (size_t)32 * 2 * NCHUNK * 2112 * 4 <= WS_HO && WS_HO + (size_t)M_ALL * 1024 * 2 <= WS_Y && WS_Y + (size_t)M_ALL * 1024 * 2 <= WS_UP, "ws map 3");
static_assert(WS_KC + (size_t)M_LAT * 1024 * 2 <= WS_HO, "parked residual");
static_assert(WS_UP + (size_t)M_ALL * PW * 2 <= WS_RW && WS_RW + 5 * SZ_ROWS256 <= WS_END && 4 * SZ_ROWS256 <= (size_t)M_ALL * 1024 * 2, "ws map 4");
constexpr int CW_BAR = 4096;
constexpr int CW_QUEUE = 16384;

enum { PT_GLA_QK = 0, PT_GLA_V = 1, PT_GLA_G = 2, PT_SWA_Q = 3, PT_SWA_KV = 4, PT_FA_Q = 5, PT_FA_KV = 6, PT_RW_R = 7, PT_RW_K = 8, PT_RW_V = 9, PT_LOW = 10 };
enum { RA_R = 0, RA_V = 1, RA_K = 2, RA_NKK = 3, RA_AF = 4, RA_AB = 5, RA_EF = 6, RA_EB = 7, RA_G = 8 };

constexpr int RING_OFF = 0, RING_BYTES = 131072;
constexpr int LDSCTL_OFF = RING_BYTES, MISC_OFF = LDSCTL_OFF + 320;
constexpr int LDS_BYTES = 147456;

#define GAS __attribute__((address_space(1)))
#define LAS __attribute__((address_space(3)))
typedef unsigned short bf16;
typedef unsigned v4u __attribute__((ext_vector_type(4)));
typedef unsigned v2u __attribute__((ext_vector_type(2)));
typedef float f32x4 __attribute__((ext_vector_type(4)));
typedef float f32x16 __attribute__((ext_vector_type(16)));
typedef short bf16x8 __attribute__((ext_vector_type(8)));
typedef GAS unsigned gu32;
#define RLX_AGENT __ATOMIC_RELAXED, __HIP_MEMORY_SCOPE_AGENT
#define LDS_WAIT() asm volatile("s_waitcnt lgkmcnt(0)" ::: "memory")
#define VM_WAIT() asm volatile("s_waitcnt vmcnt(0)" ::: "memory")
__device__ __forceinline__ unsigned f2bf(float f) { unsigned u = __builtin_bit_cast(unsigned, f); return (u + 0x7fffu + ((u >> 16) & 1u)) >> 16; }
__device__ __forceinline__ unsigned pk2(float lo, float hi) { return f2bf(lo) | (f2bf(hi) << 16); }
__device__ __forceinline__ float bflo(unsigned w) { return __uint_as_float(w << 16); }
__device__ __forceinline__ float bfhi(unsigned w) { return __uint_as_float(w & 0xffff0000u); }
__device__ __forceinline__ float bf1(bf16 v) { return __uint_as_float((unsigned)v << 16); }
__device__ __forceinline__ float fexp2(float x) { return __builtin_amdgcn_exp2f(x); }
__device__ __forceinline__ float fexp(float x) { return __builtin_amdgcn_exp2f(x * LOG2E); }
__device__ __forceinline__ float frcp(float x) { return __builtin_amdgcn_rcpf(x); }
__device__ __forceinline__ float fsigmoid(float x) { return frcp(1.0f + fexp(-x)); }
__device__ __forceinline__ float wave_sum(float v) {
#pragma unroll
    for (int o = 1; o < 64; o <<= 1) v += __shfl_xor(v, o);
    return v;
}
__device__ __forceinline__ float red8(float v) { v += __shfl_xor(v, 1); v += __shfl_xor(v, 2); v += __shfl_xor(v, 4); return v; }
typedef float f32x2_t __attribute__((ext_vector_type(2))); typedef __bf16 bf16x2_t __attribute__((ext_vector_type(2)));
__device__ __forceinline__ unsigned cvtpk(float lo, float hi) { f32x2_t v = {lo, hi}; bf16x2_t b = __builtin_convertvector(v, bf16x2_t); return __builtin_bit_cast(unsigned, b); }
#define DPP_F(v, ctrl) __int_as_float(__builtin_amdgcn_update_dpp(0, __float_as_int(v), (ctrl), 0xf, 0xf, true))
__device__ __forceinline__ float red8_dpp(float v) {
    v += DPP_F(v, 0x141);
    v += DPP_F(v, 0xB1);
    v += DPP_F(v, 0x4E);
    return v;
}
__device__ __forceinline__ float xor2_dpp(float v) { return DPP_F(v, 0x4E); }
__device__ __forceinline__ bf16x8 tr_frag(const LAS unsigned char* buf, int rowb, int cb, int ks, int lane) {
    typedef short s4v __attribute__((ext_vector_type(4)));
    const LAS unsigned char* a = buf + (32 * ks + 8 * (lane >> 4) + ((lane & 15) >> 2)) * rowb + (16 * cb + 4 * (lane & 3)) * 2;
    const s4v t0 = __builtin_amdgcn_ds_read_tr16_b64_v4i16((LAS s4v*)a), t1 = __builtin_amdgcn_ds_read_tr16_b64_v4i16((LAS s4v*)(a + 4 * rowb));
    const v2u u0 = __builtin_bit_cast(v2u, t0), u1 = __builtin_bit_cast(v2u, t1);
    return __builtin_bit_cast(bf16x8, (v4u){u0.x, u0.y, u1.x, u1.y});
}
#define XB_TMO      128
#define XB_XCNT(j)  (256  + 64 * (j))
#define XB_XSUB(j)  (1280 + 64 * (j))
#define XB_XGEN(j)  (2304 + 64 * (j))
#define XB_TOP      3328
#define XB_TOPGEN   3392
#define XCD_BAR_WORDS 3456
#define XB_SPIN_CAP (1u << 18)

__device__ __forceinline__ unsigned xb_ld(unsigned* p)              { return __hip_atomic_load(p, __ATOMIC_RELAXED, __HIP_MEMORY_SCOPE_AGENT); }
__device__ __forceinline__ unsigned xb_add(unsigned* p, unsigned v) { return __hip_atomic_fetch_add(p, v, __ATOMIC_RELAXED, __HIP_MEMORY_SCOPE_AGENT); }
__device__ __forceinline__ unsigned xb_xcc_id() { return (unsigned)__builtin_amdgcn_s_getreg((3 << 11) | 20) & 0xFu; }
#define XB_SPIN(cond, bar) do { unsigned _sp = 0; while (cond) { __builtin_amdgcn_s_sleep(1); \
    if ((++_sp & 255u) == 0u) { if (xb_ld(&(bar)[XB_TMO])) break; if (_sp > XB_SPIN_CAP) { atomicAdd(&(bar)[XB_TMO], 1u); break; } } } } while (0)

struct XcdBarrier {
    unsigned* bar; unsigned x;
    volatile LAS unsigned* st;
};

__device__ __forceinline__ XcdBarrier xcd_barrier_post(unsigned* bar, volatile LAS unsigned* st) {
    XcdBarrier b; b.bar = bar; b.x = xb_xcc_id(); b.st = st;
    if (threadIdx.x == 0) (void)xb_add(&bar[XB_XCNT(b.x)], 1u);
    return b;
}
__device__ __forceinline__ void xcd_barrier_complete(unsigned* bar, unsigned x, unsigned& nloc, unsigned& nx) {
    const unsigned G = gridDim.x * gridDim.y * gridDim.z;
    unsigned sum, cnt, mine, sp = 0u;
    for (;;) {
        sum = 0u; cnt = 0u; mine = 0u;
#pragma unroll
        for (unsigned j = 0; j < 16; ++j) { const unsigned c = xb_ld(&bar[XB_XCNT(j)]); sum += c; cnt += (c > 0u) ? 1u : 0u; mine = (j == x) ? c : mine; }
        if (sum == G) break;
        __builtin_amdgcn_s_sleep(1);
        if ((++sp & 255u) == 0u) { if (xb_ld(&bar[XB_TMO])) break; if (sp > XB_SPIN_CAP) { atomicAdd(&bar[XB_TMO], 1u); break; } }
    }
    nloc = mine > 0u ? mine : 1u; nx = cnt > 0u ? cnt : 1u;
}

__device__ __forceinline__ void xcd_barrier(const XcdBarrier& b) {
    asm volatile("s_waitcnt vmcnt(0)" ::: "memory");
    __syncthreads();
    if (threadIdx.x == 0) {
        unsigned* bar = b.bar;
        __builtin_amdgcn_s_waitcnt(0);
        unsigned nloc = b.st[0], nx = b.st[1];
        if (nloc == 0u) { xcd_barrier_complete(bar, b.x, nloc, nx); b.st[0] = nloc; b.st[1] = nx; }
        const unsigned old = xb_add(&bar[XB_XSUB(b.x)], 1u);
        const unsigned gen = old / nloc;
        if (old + 1u == (gen + 1u) * nloc) {
            __builtin_amdgcn_fence(__ATOMIC_RELEASE, "agent");
            asm volatile("s_waitcnt vmcnt(0)" ::: "memory");
            const unsigned og = xb_add(&bar[XB_TOP], 1u);
            const unsigned tg = og / nx;
            if (og + 1u == (tg + 1u) * nx) xb_add(&bar[XB_TOPGEN], 1u);
            else XB_SPIN(xb_ld(&bar[XB_TOPGEN]) == tg, bar);
            __builtin_amdgcn_fence(__ATOMIC_ACQUIRE, "agent");
            xb_add(&bar[XB_XGEN(b.x)], 1u);
            asm volatile("s_waitcnt vmcnt(0)" ::: "memory");
        } else {
            XB_SPIN(xb_ld(&bar[XB_XGEN(b.x)]) == gen, bar);
            __builtin_amdgcn_fence(__ATOMIC_ACQUIRE, "agent");
            asm volatile("s_waitcnt vmcnt(0)" ::: "memory");
        }
    }
    __syncthreads();
}
struct Frame {
    LAS unsigned char* lds;
    volatile LAS unsigned* MISC;
    gu32* ctl;
    int tid, lane, wave;
    int vcu, G, bid;
    const float* in[28];
    float* out; unsigned char* ws;
};
enum { I_X = 0, I_C, I_CTX, I_CCTX, I_WMOD, I_BMOD, I_NORMG, I_W13, I_W2, I_WIN, I_WOUT, I_GLA_WA2, I_GLA_BA, I_GLA_ONORM, I_SWA_SINK, I_FA_QN, I_FA_KN,
       I_RW_MU, I_RW_W0, I_RW_W2, I_RW_A0, I_RW_A2, I_RW_G2, I_RW_KK, I_RW_KA, I_RW_RK, I_RW_LNW, I_RW_LNB };

__device__ __forceinline__ bf16* ptile(const Frame& F, int t) { return (bf16*)(F.ws + WS_UP) + (size_t)t * M_ALL * 256; }
__device__ __forceinline__ bf16* rwarr(const Frame& F, int a) { return (bf16*)(F.ws + (a < 4 ? WS_Y + (size_t)a * SZ_ROWS256 : WS_RW + (size_t)(a - 4) * SZ_ROWS256)); }
__device__ __forceinline__ int chunk_row0(int b, int c) { return c < 4 ? M_LAT + b * CTXL + 64 * c : b * SEQ + 64 * (c - 4); }
__device__ __forceinline__ int scan_chunk(int dir, int s) { return dir == 0 ? s : (s < 4 ? 3 - s : 135 - s); }

__device__ __forceinline__ void p0_transpose_item(const float* W, int K, int Nsrc, bf16* WT, int k0, int n0, int src0, LAS float* scr, int lane) {
    float tv[32];
#pragma unroll
    for (int i = 0; i < 32; ++i) { const int kk = 2 * i + (lane >> 5); tv[i] = src0 >= 0 ? W[(size_t)(k0 + kk) * Nsrc + src0 + (lane & 31)] : 0.f; }
#pragma unroll
    for (int i = 0; i < 32; ++i) { const int kk = 2 * i + (lane >> 5); scr[kk * 33 + (lane & 31)] = tv[i]; }
    LDS_WAIT(); asm volatile("" ::: "memory");
    const int c = lane & 7;
#pragma unroll
    for (int j = 0; j < 4; ++j) { const int n = (lane >> 3) + 8 * j; const LAS float* s = scr + (8 * c) * 33 + n;
        v4u o; o.x = pk2(s[0 * 33], s[1 * 33]); o.y = pk2(s[2 * 33], s[3 * 33]); o.z = pk2(s[4 * 33], s[5 * 33]); o.w = pk2(s[6 * 33], s[7 * 33]);
        *(GAS v4u*)(WT + (size_t)(n0 + n) * K + k0 + 8 * c) = o; }
    LDS_WAIT(); asm volatile("" ::: "memory");
}
__device__ __forceinline__ int win_src(int n) {
    if (n < 768) return n;
    if (n < 1280) return 800 + (n - 768);
    if (n < 1792) return 1312 + (n - 1280);
    if (n < 2560) return 1824 + (n - 1792);
    if (n < 2592) return 768 + (n - 2560);
    if (n < 2784) return n;
    return -1;
}
template <int PART>
__device__ __forceinline__ void p0_prologue(Frame& F) {
    LAS float* scr = (LAS float*)(F.lds + RING_OFF + F.wave * 16384);
    const int gw = F.vcu * NWAVES + F.wave, NGW = F.G * NWAVES;
    if constexpr (PART & 2) {
    constexpr int I13 = 16 * 176, I2 = 44 * 32, IIN = 16 * 88, IOUT = 16 * 32;
    constexpr int NIT = 4 * I13 + 4 * I2 + 2 * IIN + 2 * IOUT;
    for (int it = gw; it < NIT; it += NGW) {
        int r = it;
        if (r < 4 * I13) { const int mi = r / I13, q = r % I13, kb = q / 176, nb = q % 176, n0 = nb * 32;
            const int pn = n0 >> 8, within = n0 & 255, bj = within >> 7, j = within & 127, src0 = bj * DFF + pn * 128 + j;
            p0_transpose_item(F.in[I_W13] + (size_t)mi * DM * 2 * DFF, DM, 2 * DFF, (bf16*)(F.ws + WS_W13) + (size_t)mi * 2 * DFF * DM, kb * 64, n0, src0, scr, F.lane); continue; }
        r -= 4 * I13;
        if (r < 4 * I2) { const int mi = r / I2, q = r % I2, kb = q / 32, nb = q % 32;
            p0_transpose_item(F.in[I_W2] + (size_t)mi * DFF * DM, DFF, DM, (bf16*)(F.ws + WS_W2) + (size_t)mi * DM * DFF, kb * 64, nb * 32, nb * 32, scr, F.lane); continue; }
        r -= 4 * I2;
        if (r < 2 * IIN) { const int mi = r / IIN, q = r % IIN, kb = q / 88, nb = q % 88;
            p0_transpose_item(F.in[I_WIN] + (size_t)mi * DM * PIN, DM, PIN, (bf16*)(F.ws + WS_WIN) + (size_t)mi * PW * DM, kb * 64, nb * 32, win_src(nb * 32), scr, F.lane); continue; }
        r -= 2 * IIN;
        { const int mi = r / IOUT, q = r % IOUT, kb = q / 32, nb = q % 32;
            p0_transpose_item(F.in[I_WOUT] + (size_t)mi * DM * DM, DM, DM, (bf16*)(F.ws + WS_WOUT) + (size_t)mi * DM * DM, kb * 64, nb * 32, nb * 32, scr, F.lane); }
    }
    __syncthreads();
    }
    if constexpr (PART & 1) {
        LAS float* sc = (LAS float*)(F.lds + RING_OFF);
        LAS float* red = sc + 9 * 1024;
        for (int i = F.tid; i < 9 * 1024; i += NTHREADS) { const int mi = i >> 10, k = i & 1023; const float v = mi < 8 ? F.in[I_C][mi * 1024 + k] : F.in[I_CCTX][k]; sc[i] = v * fsigmoid(v); }
        __syncthreads();
        float* modv = (float*)(F.ws + WS_MODV);
        for (int it = F.vcu; it < 2 * 144; it += F.G) {
            const int l = it / 144, n = (it % 144) * 64 + F.lane;
            const float* wm = F.in[I_WMOD] + (size_t)l * DM * 9216 + n;
            float acc[9];
#pragma unroll
            for (int mi = 0; mi < 9; ++mi) acc[mi] = 0.f;
#pragma unroll 16
            for (int i = 0; i < 128; ++i) { const int k = F.wave + 8 * i; const float w = wm[(size_t)k * 9216];
#pragma unroll
                for (int mi = 0; mi < 9; ++mi) acc[mi] += sc[mi * 1024 + k] * w; }
#pragma unroll
            for (int mi = 0; mi < 9; ++mi) red[(F.wave * 9 + mi) * 64 + F.lane] = acc[mi];
            __syncthreads();
            for (int o = F.tid; o < 9 * 64; o += NTHREADS) { const int mi = o >> 6, c = o & 63; float s = 0.f;
#pragma unroll
                for (int w = 0; w < 8; ++w) s += red[(w * 9 + mi) * 64 + c];
                const int nn = (it % 144) * 64 + c; modv[((size_t)l * 9 + mi) * 9216 + nn] = s + F.in[I_BMOD][l * 9216 + nn]; }
            __syncthreads();
        }
    }
    if constexpr (PART & 2) {
        bf16* wt = (bf16*)(F.ws + WS_RWWT);
        for (int i = F.vcu * NTHREADS + F.tid; i < 2 * 49152; i += F.G * NTHREADS) {
            const int l = i / 49152, q = i % 49152; float v;
            if (q < 32768) { const int pq = q >> 13, ch = (q >> 5) & 255, k = q & 31; const float* src = (pq < 2 ? F.in[I_RW_W2] : F.in[I_RW_A2]) + ((size_t)(l * 2 + (pq & 1)) * 32 + k) * 256 + ch; v = *src; }
            else { const int q2 = q - 32768, ch = q2 >> 6, k = q2 & 63; v = F.in[I_RW_G2][((size_t)l * 64 + k) * 256 + ch]; }
            wt[i] = (bf16)f2bf(v);
        }
    }
    if ((PART & 2) && F.vcu == F.G - 1) {
        float* rt = (float*)(F.ws + WS_ROPE);
        for (int i = F.tid; i < 192 * 16; i += NTHREADS) { const int pos = i >> 4, j = i & 15; const float p = pos < 128 ? (float)pos : (float)(pos - 128);
            const float inv = exp2f(-(float)j * (13.287712379549449f / 16.0f)); const float ang = p * inv; float s, c; sincosf(ang, &s, &c); rt[2 * i] = c; rt[2 * i + 1] = s; }
    }
}

template <bool HAS_RES, bool HAS_NEXT, bool XIN_BF = false, bool XOUT_BF = false>
__device__ __forceinline__ void thin_phase(Frame& F, const bf16* aY, const void* xsrc_lat, const float* xsrc_ctx, void* xdst_lat, float* xdst_ctx,
                                           const float* gpost, const float* gate  , float coef,
                                           const float* gpre, const float* shiftv, const float* scalev  , bf16* aH, int nrows) {
    const int gw = F.vcu * NWAVES + F.wave, NGW = F.G * NWAVES;
    const int per = (nrows + NGW - 1) / NGW; const int r0 = gw * per, r1 = min(nrows, r0 + per);
    f32x4 cg[4], sc[4], sh[4]; int cur_mi = -1;
    f32x4 xnA[4], xnB[4]; v2u xnbA[4], xnbB[4], ynA[4], ynB[4];
#define THIN_LOAD(XN, XNB, YN, r_) do { const int rr_ = (r_); \
        if (XIN_BF && rr_ < M_LAT) { const bf16* xs_ = (const bf16*)xsrc_lat + (size_t)rr_ * DM; \
            _Pragma("unroll") for (int j = 0; j < 4; ++j) XNB[j] = *(const v2u*)(xs_ + 4 * F.lane + 256 * j); } \
        else { const float* xs_ = rr_ < M_LAT ? (const float*)xsrc_lat + (size_t)rr_ * DM : xsrc_ctx + (size_t)(rr_ - M_LAT) * DM; \
            _Pragma("unroll") for (int j = 0; j < 4; ++j) XN[j] = *(const f32x4*)(xs_ + 4 * F.lane + 256 * j); } \
        if (HAS_RES) { _Pragma("unroll") for (int j = 0; j < 4; ++j) YN[j] = *(const v2u*)(aY + (size_t)rr_ * DM + 4 * F.lane + 256 * j); } } while (0)
#define THIN_ROW(XN, XNB, YN, r_) do { const int r = (r_); \
        const int mi = r < M_LAT ? (r >> 13) : 8; \
        if (mi != cur_mi) { cur_mi = mi; \
            _Pragma("unroll") for (int j = 0; j < 4; ++j) { const int c = 4 * F.lane + 256 * j; \
                if (HAS_RES) { const f32x4 g = *(const f32x4*)(gate + (size_t)mi * 9216 + c), p = *(const f32x4*)(gpost + c); cg[j] = g * p * coef; } \
                if (HAS_NEXT) { const f32x4 s = *(const f32x4*)(scalev + (size_t)mi * 9216 + c), p = *(const f32x4*)(gpre + c); sc[j] = p * (s + 1.0f); \
                    sh[j] = *(const f32x4*)(shiftv + (size_t)mi * 9216 + c); } } } \
        f32x4 x[4]; v2u yw[4]; \
        if (XIN_BF && r < M_LAT) { _Pragma("unroll") for (int j = 0; j < 4; ++j) { const v2u w = XNB[j]; x[j] = (f32x4){bflo(w.x), bfhi(w.x), bflo(w.y), bfhi(w.y)}; } } \
        else { _Pragma("unroll") for (int j = 0; j < 4; ++j) x[j] = XN[j]; } \
        _Pragma("unroll") for (int j = 0; j < 4; ++j) { if (HAS_RES) yw[j] = YN[j]; } \
        if (r + 2 < r1) THIN_LOAD(XN, XNB, YN, r + 2); \
        if (HAS_RES) { \
            f32x4 y[4]; float s = 0.f; \
            _Pragma("unroll") for (int j = 0; j < 4; ++j) { const v2u w = yw[j]; y[j] = (f32x4){bflo(w.x), bfhi(w.x), bflo(w.y), bfhi(w.y)}; \
                s += (y[j].x * y[j].x + y[j].y * y[j].y) + (y[j].z * y[j].z + y[j].w * y[j].w); } \
            const float rstd = 1.0f / sqrtf(wave_sum(s) * (1.0f / DM) + NORM_EPS); \
            _Pragma("unroll") for (int j = 0; j < 4; ++j) x[j] = x[j] + cg[j] * (y[j] * rstd); \
            if (XOUT_BF && r < M_LAT) { bf16* xd = (bf16*)xdst_lat + (size_t)r * DM; \
                _Pragma("unroll") for (int j = 0; j < 4; ++j) { v2u w; w.x = cvtpk(x[j].x, x[j].y); w.y = cvtpk(x[j].z, x[j].w); *(v2u*)(xd + 4 * F.lane + 256 * j) = w; } \
            } else { float* xd = r < M_LAT ? (float*)xdst_lat + (size_t)r * DM : xdst_ctx + (size_t)(r - M_LAT) * DM; \
                _Pragma("unroll") for (int j = 0; j < 4; ++j) *(f32x4*)(xd + 4 * F.lane + 256 * j) = x[j]; \
            } \
        } \
        if (HAS_NEXT) { \
            float s = 0.f; \
            _Pragma("unroll") for (int j = 0; j < 4; ++j) s += (x[j].x * x[j].x + x[j].y * x[j].y) + (x[j].z * x[j].z + x[j].w * x[j].w); \
            const float rstd = 1.0f / sqrtf(wave_sum(s) * (1.0f / DM) + NORM_EPS); \
            _Pragma("unroll") for (int j = 0; j < 4; ++j) { const f32x4 h = (x[j] * rstd) * sc[j] + sh[j]; v2u w; w.x = pk2(h.x, h.y); w.y = pk2(h.z, h.w); \
                *(v2u*)(aH + (size_t)r * DM + 4 * F.lane + 256 * j) = w; } \
        } } while (0)
    if (r0 < r1) THIN_LOAD(xnA, xnbA, ynA, r0);
    if (r0 + 1 < r1) THIN_LOAD(xnB, xnbB, ynB, r0 + 1);
    for (int rb = r0; rb < r1; rb += 2) {
        THIN_ROW(xnA, xnbA, ynA, rb);
        if (rb + 1 < r1) THIN_ROW(xnB, xnbB, ynB, rb + 1);
    }
#undef THIN_ROW
#undef THIN_LOAD
}
struct LayerW {
    const float *gla_wa2, *gla_ba, *gla_onorm, *swa_sink, *fa_qn, *fa_kn;
    const float *rw_mu, *rw_w0, *rw_w2, *rw_a0, *rw_a2, *rw_g2, *rw_kk, *rw_ka, *rw_rk, *rw_lnw, *rw_lnb;
};
__device__ __forceinline__ LayerW layer_w(const Frame& F, int l) {
    LayerW W;
    W.gla_wa2 = F.in[I_GLA_WA2] + (size_t)l * 2 * 16 * 128; W.gla_ba = F.in[I_GLA_BA] + l * 2 * 128; W.gla_onorm = F.in[I_GLA_ONORM] + l * 64;
    W.swa_sink = F.in[I_SWA_SINK] + l * 4; W.fa_qn = F.in[I_FA_QN] + l * 64; W.fa_kn = F.in[I_FA_KN] + l * 64;
    W.rw_mu = F.in[I_RW_MU] + (size_t)l * 2 * 960; W.rw_w0 = F.in[I_RW_W0] + l * 2 * 256; W.rw_w2 = F.in[I_RW_W2] + (size_t)l * 2 * 32 * 256;
    W.rw_a0 = F.in[I_RW_A0] + l * 2 * 256; W.rw_a2 = F.in[I_RW_A2] + (size_t)l * 2 * 32 * 256; W.rw_g2 = F.in[I_RW_G2] + (size_t)l * 64 * 256;
    W.rw_kk = F.in[I_RW_KK] + l * 256; W.rw_ka = F.in[I_RW_KA] + l * 256; W.rw_rk = F.in[I_RW_RK] + l * 256; W.rw_lnw = F.in[I_RW_LNW] + l * 256; W.rw_lnb = F.in[I_RW_LNB] + l * 256;
    return W;
}
#define UNPK4(q_) {bflo(q_.x), bfhi(q_.x), bflo(q_.y), bfhi(q_.y), bflo(q_.z), bfhi(q_.z), bflo(q_.w), bfhi(q_.w)}
__device__ __forceinline__ int opaque0() { int z; asm volatile("s_mov_b32 %0, 0" : "=s"(z)); return z; }
__device__ __forceinline__ void tile_info(int tt, int& row0, int& b, int& key0, int& t0, bool& lat) {
    if (tt < 1024) { b = tt >> 7; t0 = (tt & 127) * 64; row0 = b * SEQ + t0; key0 = t0; lat = true; }
    else { const int cc = tt - 1024; b = cc >> 2; t0 = (cc & 3) * 64; row0 = M_LAT + b * CTXL + t0; key0 = SEQ + t0; lat = false; }
}

constexpr int ROPE_LDS_OFF = RING_OFF + 40960;
__device__ __forceinline__ void rope_stage(Frame& F) {
    const f32x4* src = (const f32x4*)(F.ws + WS_ROPE) + opaque0(); LAS f32x4* dst = (LAS f32x4*)(F.lds + ROPE_LDS_OFF);
#pragma unroll
    for (int q = 0; q < 3; ++q) dst[q * NTHREADS + F.tid] = src[q * NTHREADS + F.tid];
    __syncthreads();
}
__device__ __forceinline__ void attn_prep_tile(Frame& F, const LayerW& W, int tt, int rep = 0) {
    int row0, b, key0, t0; bool lat; tile_info(tt, row0, b, key0, t0, lat);
    const int tok8 = F.tid >> 6, slot = (F.tid >> 3) & 7, s = F.tid & 7;
    const LAS float* ropeL = (const LAS float*)(F.lds + ROPE_LDS_OFF);
    const int mix = slot >> 2, isv = (slot >> 1) & 1, hh = slot & 1;
    const bf16* src0 = ptile(F, mix ? PT_FA_KV : PT_SWA_KV) + (isv ? 128 : 0) + hh * 64 + 8 * s;
    bf16* dst0 = (bf16*)(F.ws + (isv ? WS_VT : WS_KC)) + ((size_t)((b * 2 + mix) * 2 + hh) * NKEY + key0) * 64 + 8 * s;
    float gain[8];
    { const float* gq = W.fa_kn + opaque0();
#pragma unroll
      for (int e = 0; e < 8; ++e) gain[e] = mix ? gq[8 * s + e] : 1.0f; }
    (void)rep;
    v4u win[8];
#pragma unroll
    for (int u2 = 0; u2 < 8; ++u2) win[u2] = *(const v4u*)(src0 + ((size_t)row0 + u2 * 8 + tok8) * 256);
#pragma unroll
    for (int u2 = 0; u2 < 8; ++u2) {
        const int tk = u2 * 8 + tok8;
        const v4u w = win[u2];
#if ATT_VTR
        if (isv) { *(v4u*)(dst0 + (size_t)tk * 64) = w; continue; }
#else
        if (isv) { const unsigned ww[4] = {w.x, w.y, w.z, w.w}; LAS bf16* vtb = (LAS bf16*)(F.lds + RING_OFF);
#pragma unroll
            for (int e = 0; e < 8; ++e) vtb[((mix * 2 + hh) * 64 + 8 * s + e) * 72 + (tk ^ (s << 3))] = (bf16)((e & 1) ? (ww[e >> 1] >> 16) : (ww[e >> 1] & 0xffffu));
            continue; }
#endif
        float x[8] = {bflo(w.x), bfhi(w.x), bflo(w.y), bfhi(w.y), bflo(w.z), bfhi(w.z), bflo(w.w), bfhi(w.w)};
        if (mix) {
            float ss = 0.f;
#pragma unroll
            for (int e = 0; e < 8; ++e) ss += x[e] * x[e];
            ss = red8_dpp(ss); const float rstd = __builtin_amdgcn_rsqf(ss * (1.0f / 64.0f) + NORM_EPS);
#pragma unroll
            for (int e = 0; e < 8; ++e) x[e] = x[e] * rstd * gain[e];
        }
        float y[8];
        if (lat) {
            const LAS float* tab = ropeL + ((s < 4) ? (t0 >> 6) * 32 : 128 * 32 + tk * 32) + 16 * (s & 1);
            const f32x4 c0 = *(const LAS f32x4*)tab, c1 = *(const LAS f32x4*)(tab + 4), c2 = *(const LAS f32x4*)(tab + 8), c3 = *(const LAS f32x4*)(tab + 12);
            const float cs[16] = {c0.x, c0.y, c0.z, c0.w, c1.x, c1.y, c1.z, c1.w, c2.x, c2.y, c2.z, c2.w, c3.x, c3.y, c3.z, c3.w};
            const float sgn = (s & 2) ? 1.0f : -1.0f;
#pragma unroll
            for (int e = 0; e < 8; ++e) { const float pr = xor2_dpp(x[e]); y[e] = x[e] * cs[2 * e] + sgn * pr * cs[2 * e + 1]; }
        } else {
#pragma unroll
            for (int e = 0; e < 8; ++e) y[e] = x[e];
        }
        v4u o; o.x = cvtpk(y[0], y[1]); o.y = cvtpk(y[2], y[3]); o.z = cvtpk(y[4], y[5]); o.w = cvtpk(y[6], y[7]);
        *(v4u*)(dst0 + (size_t)tk * 64) = o;
    }
#if !ATT_VTR
    __syncthreads();
    {
        LAS bf16* vtb = (LAS bf16*)(F.lds + RING_OFF);
        const int rw = F.tid >> 1, half = F.tid & 1, combo = rw >> 6, d = rw & 63;
        bf16* VT = (bf16*)(F.ws + WS_VT) + ((size_t)(b * 4 + combo) * 64 + d) * NKEY + key0 + half * 32;
#pragma unroll
        for (int q = 0; q < 4; ++q) *(v4u*)(VT + 8 * q) = *(const LAS v4u*)(vtb + (combo * 64 + d) * 72 + (((half * 4 + q) ^ ((d >> 3) & 7)) << 3));
    }
    __syncthreads();
#endif
}

__device__ __forceinline__ void rw_expand(const LAS float* LOW, LAS float* ZP, const float* wsrc, float bias, float osc, int lowoff, bf16* dst, int mode, int row0, int par, int c) {
    float w[32];
    int zero; asm volatile("s_mov_b32 %0, 0" : "=s"(zero));
    wsrc += zero;
#pragma unroll
    for (int j = 0; j < 32; ++j) w[j] = wsrc[(size_t)j * 256];
#pragma unroll 1
    for (int i = 0; i < 32; ++i) {
        const int tk = 2 * i + par; const size_t row = (size_t)row0 + tk; const LAS float* lp = LOW + tk * 192 + lowoff;
        float z = mode == 2 ? ZP[tk * 256 + c] : bias;
#pragma unroll
        for (int q = 0; q < 8; ++q) { const f32x4 v = *(const LAS f32x4*)(lp + 4 * q); z += v.x * w[4 * q] + v.y * w[4 * q + 1] + v.z * w[4 * q + 2] + v.w * w[4 * q + 3]; }
        if (mode == 1) ZP[tk * 256 + c] = z;
        else dst[row * 256 + c] = (bf16)f2bf(mode == 0 ? osc * fsigmoid(z) : z);
    }
}
__device__ __forceinline__ void rwkv_base_stream(Frame& F, const LayerW& W) {
    const int oz = opaque0();
    const float* mu0 = W.rw_mu + oz, *mu1 = W.rw_mu + 960 + oz;
    const int hwi = (F.vcu * NWAVES + F.wave) * 2 + (F.lane >> 5), NHW = F.G * NWAVES * 2, hc = F.lane & 31, c0 = hc * 8;
    const int per = (M_ALL + NHW - 1) / NHW, rbeg = hwi * per, rend = min(M_ALL, rbeg + per);
    const bf16* pr = ptile(F, PT_RW_R) + c0; const bf16* pk = ptile(F, PT_RW_K) + c0; const bf16* pv = ptile(F, PT_RW_V) + c0;
    bf16* oR = rwarr(F, RA_R) + c0; bf16* oV = rwarr(F, RA_V) + c0; bf16* oK = rwarr(F, RA_K) + c0; bf16* oN = rwarr(F, RA_NKK) + c0;
    float kkc[8], m0r[8], m1r[8], m0k[8], m1k[8], m0v[8], m1v[8];
#pragma unroll
    for (int e = 0; e < 8; ++e) { kkc[e] = (W.rw_kk + oz)[c0 + e]; m0r[e] = mu0[c0 + e]; m1r[e] = mu1[c0 + e]; m0k[e] = mu0[256 + c0 + e]; m1k[e] = mu1[256 + c0 + e]; m0v[e] = mu0[512 + c0 + e]; m1v[e] = mu1[512 + c0 + e]; }
    const v4u z4 = (v4u){0, 0, 0, 0};
    v4u rA = z4, kA = z4, vA = z4, rB = z4, kB = z4, vB = z4, rC = z4, kC = z4, vC = z4, rD = z4, kD = z4, vD = z4;
#define RB_LOAD(R_, K_, V_, row_) do { const int rr_ = (row_); if (rr_ >= 0 && rr_ < M_ALL) { const size_t o_ = (size_t)rr_ * 256; R_ = *(const v4u*)(pr + o_); K_ = *(const v4u*)(pk + o_); V_ = *(const v4u*)(pv + o_); } } while (0)
#define RB_STEP(row_, RP, KP, VP, RC_, KC_, VC_, RN, KN, VN, RNN, KNN, VNN) do { const int rw_ = (row_); \
        if (rw_ < rend) { \
        RB_LOAD(RNN, KNN, VNN, rw_ + 2); \
        const int t = rw_ < M_LAT ? (rw_ & (SEQ - 1)) : ((rw_ - M_LAT) & (CTXL - 1)); const bool hp = t > 0, hn = t < (rw_ < M_LAT ? SEQ : CTXL) - 1; \
        const v4u rp4 = hp ? RP : z4, kp4 = hp ? KP : z4, vp4 = hp ? VP : z4, rn4 = hn ? RN : z4, kn4 = hn ? KN : z4, vn4 = hn ? VN : z4; \
        const float rc[8] = UNPK4(RC_), kc[8] = UNPK4(KC_), vc[8] = UNPK4(VC_), rp[8] = UNPK4(rp4), kp[8] = UNPK4(kp4), vp[8] = UNPK4(vp4), rn[8] = UNPK4(rn4), kn[8] = UNPK4(kn4), vn[8] = UNPK4(vn4); \
        float rs[8], ks[8], vs[8], kr[8], ss = 0.f; \
        _Pragma("unroll") for (int e = 0; e < 8; ++e) { rs[e] = rc[e] + m0r[e] * (rp[e] - rc[e]) + m1r[e] * (rn[e] - rc[e]); ks[e] = kc[e] + m0k[e] * (kp[e] - kc[e]) + m1k[e] * (kn[e] - kc[e]); \
            vs[e] = vc[e] + m0v[e] * (vp[e] - vc[e]) + m1v[e] * (vn[e] - vc[e]); kr[e] = ks[e] * kkc[e]; ss += kr[e] * kr[e]; } \
        ss = red8_dpp(ss); const float nrm = -1.0f / sqrtf(fmaxf(ss, 1e-24f)); \
        const size_t off = (size_t)rw_ * 256; v4u o; \
        o.x = cvtpk(rs[0], rs[1]); o.y = cvtpk(rs[2], rs[3]); o.z = cvtpk(rs[4], rs[5]); o.w = cvtpk(rs[6], rs[7]); *(v4u*)(oR + off) = o; \
        o.x = cvtpk(vs[0], vs[1]); o.y = cvtpk(vs[2], vs[3]); o.z = cvtpk(vs[4], vs[5]); o.w = cvtpk(vs[6], vs[7]); *(v4u*)(oV + off) = o; \
        o.x = cvtpk(ks[0], ks[1]); o.y = cvtpk(ks[2], ks[3]); o.z = cvtpk(ks[4], ks[5]); o.w = cvtpk(ks[6], ks[7]); *(v4u*)(oK + off) = o; \
        o.x = cvtpk(kr[0] * nrm, kr[1] * nrm); o.y = cvtpk(kr[2] * nrm, kr[3] * nrm); o.z = cvtpk(kr[4] * nrm, kr[5] * nrm); o.w = cvtpk(kr[6] * nrm, kr[7] * nrm); *(v4u*)(oN + off) = o; } } while (0)
    if (rbeg < rend) { RB_LOAD(rA, kA, vA, rbeg - 1); RB_LOAD(rB, kB, vB, rbeg); RB_LOAD(rC, kC, vC, rbeg + 1); }
    for (int row = rbeg; row < rend; row += 4) {
        RB_STEP(row,     rA, kA, vA, rB, kB, vB, rC, kC, vC, rD, kD, vD);
        RB_STEP(row + 1, rB, kB, vB, rC, kC, vC, rD, kD, vD, rA, kA, vA);
        RB_STEP(row + 2, rC, kC, vC, rD, kD, vD, rA, kA, vA, rB, kB, vB);
        RB_STEP(row + 3, rD, kD, vD, rA, kA, vA, rB, kB, vB, rC, kC, vC);
    }
#undef RB_LOAD
#undef RB_STEP
}
#ifndef RW_BASE_IN_TILE
#define RW_BASE_IN_TILE 1
#endif
#ifndef RWP_VAR
#define RWP_VAR 0
#endif
__device__ __forceinline__ void rwkv_prep_tile(Frame& F, const LayerW& W, int tt, int lyr, int rep = 0) {
    int row0, b, key0, t0; bool lat; tile_info(tt, row0, b, key0, t0, lat);
    const int seqlen = lat ? SEQ : CTXL;
    LAS bf16* LOWB = (LAS bf16*)(F.lds + RING_OFF);
    const int oz = opaque0();
    const float* mu0 = W.rw_mu + oz, *mu1 = W.rw_mu + 960 + oz;
    if (!((RWP_VAR & 1) && rep)) {
        const int tk = F.tid >> 3, cg = F.tid & 7; const int t = t0 + tk; const size_t row = (size_t)row0 + tk;
        const bf16* lt = ptile(F, PT_LOW) + row * 256 + 32 + cg * 24;
        const float* mp = mu0 + 768 + cg * 24; const float* mn = mu1 + 768 + cg * 24; LAS bf16* lw = LOWB + tk * 200 + cg * 24;
        const bool hp = t > 0, hn = t < seqlen - 1;
#pragma unroll
        for (int q = 0; q < 3; ++q) {
            const v4u wc = *(const v4u*)(lt + q * 8);
            v4u wp = (v4u){0, 0, 0, 0}, wn = (v4u){0, 0, 0, 0};
            if (hp) wp = *(const v4u*)(lt - 256 + q * 8);
            if (hn) wn = *(const v4u*)(lt + 256 + q * 8);
            const float c[8] = {bflo(wc.x), bfhi(wc.x), bflo(wc.y), bfhi(wc.y), bflo(wc.z), bfhi(wc.z), bflo(wc.w), bfhi(wc.w)};
            const float p[8] = {bflo(wp.x), bfhi(wp.x), bflo(wp.y), bfhi(wp.y), bflo(wp.z), bfhi(wp.z), bflo(wp.w), bfhi(wp.w)};
            const float n[8] = {bflo(wn.x), bfhi(wn.x), bflo(wn.y), bfhi(wn.y), bflo(wn.z), bfhi(wn.z), bflo(wn.w), bfhi(wn.w)};
            const int j0 = cg * 24 + q * 8;
            float v[8];
#pragma unroll
            for (int e = 0; e < 8; ++e) v[e] = c[e] + mp[q * 8 + e] * (p[e] - c[e]) + mn[q * 8 + e] * (n[e] - c[e]);
            if (j0 < 64) {
#pragma unroll
                for (int e = 0; e < 8; ++e) v[e] = 1.0f - 2.0f * frcp(1.0f + fexp(2.0f * v[e]));
            } else if (j0 >= 128) {
#pragma unroll
                for (int e = 0; e < 8; ++e) v[e] = fsigmoid(v[e]);
            }
            *(LAS v4u*)(lw + q * 8) = (v4u){cvtpk(v[0], v[1]), cvtpk(v[2], v[3]), cvtpk(v[4], v[5]), cvtpk(v[6], v[7])};
        }
    }
    __syncthreads();
    const int h = F.wave & 3, par = F.wave >> 2, c = h * 64 + F.lane;
    bf16* pr = ptile(F, PT_RW_R); bf16* pk = ptile(F, PT_RW_K); bf16* pv = ptile(F, PT_RW_V);
    if (RW_BASE_IN_TILE && !((RWP_VAR & 2) && rep)) {
        const int hc = F.tid & 31, c0 = hc * 8;
        float kkc[8], m0r[8], m1r[8], m0k[8], m1k[8], m0v[8], m1v[8];
#pragma unroll
        for (int e = 0; e < 8; ++e) { kkc[e] = (W.rw_kk + oz)[c0 + e]; m0r[e] = mu0[c0 + e]; m1r[e] = mu1[c0 + e]; m0k[e] = mu0[256 + c0 + e]; m1k[e] = mu1[256 + c0 + e]; m0v[e] = mu0[512 + c0 + e]; m1v[e] = mu1[512 + c0 + e]; }
#pragma unroll 2
        for (int q = 0; q < 4; ++q) {
            const int tk = q * 16 + (F.tid >> 5), t = t0 + tk; const size_t off = ((size_t)row0 + tk) * 256 + c0; const bool hp = t > 0, hn = t < seqlen - 1;
            const v4u z4 = (v4u){0, 0, 0, 0};
            const v4u rc4 = *(const v4u*)(pr + off), kc4 = *(const v4u*)(pk + off), vc4 = *(const v4u*)(pv + off);
            const v4u rp4 = hp ? *(const v4u*)(pr + off - 256) : z4, kp4 = hp ? *(const v4u*)(pk + off - 256) : z4, vp4 = hp ? *(const v4u*)(pv + off - 256) : z4;
            const v4u rn4 = hn ? *(const v4u*)(pr + off + 256) : z4, kn4 = hn ? *(const v4u*)(pk + off + 256) : z4, vn4 = hn ? *(const v4u*)(pv + off + 256) : z4;
            const float rc[8] = UNPK4(rc4), kc[8] = UNPK4(kc4), vc[8] = UNPK4(vc4), rp[8] = UNPK4(rp4), kp[8] = UNPK4(kp4), vp[8] = UNPK4(vp4), rn[8] = UNPK4(rn4), kn[8] = UNPK4(kn4), vn[8] = UNPK4(vn4);
            float rs[8], ks[8], vs[8], kr[8], ss = 0.f;
#pragma unroll
            for (int e = 0; e < 8; ++e) { rs[e] = rc[e] + m0r[e] * (rp[e] - rc[e]) + m1r[e] * (rn[e] - rc[e]); ks[e] = kc[e] + m0k[e] * (kp[e] - kc[e]) + m1k[e] * (kn[e] - kc[e]);
                vs[e] = vc[e] + m0v[e] * (vp[e] - vc[e]) + m1v[e] * (vn[e] - vc[e]); kr[e] = ks[e] * kkc[e]; ss += kr[e] * kr[e]; }
            ss = red8_dpp(ss); const float nrm = -1.0f / sqrtf(fmaxf(ss, 1e-24f));
            v4u o;
            o.x = cvtpk(rs[0], rs[1]); o.y = cvtpk(rs[2], rs[3]); o.z = cvtpk(rs[4], rs[5]); o.w = cvtpk(rs[6], rs[7]); *(v4u*)(rwarr(F, RA_R) + off) = o;
            o.x = cvtpk(vs[0], vs[1]); o.y = cvtpk(vs[2], vs[3]); o.z = cvtpk(vs[4], vs[5]); o.w = cvtpk(vs[6], vs[7]); *(v4u*)(rwarr(F, RA_V) + off) = o;
            o.x = cvtpk(ks[0], ks[1]); o.y = cvtpk(ks[2], ks[3]); o.z = cvtpk(ks[4], ks[5]); o.w = cvtpk(ks[6], ks[7]); *(v4u*)(rwarr(F, RA_K) + off) = o;
            o.x = cvtpk(kr[0] * nrm, kr[1] * nrm); o.y = cvtpk(kr[2] * nrm, kr[3] * nrm); o.z = cvtpk(kr[4] * nrm, kr[5] * nrm); o.w = cvtpk(kr[6] * nrm, kr[7] * nrm); *(v4u*)(rwarr(F, RA_NKK) + off) = o;
        }
    }
    if (!((RWP_VAR & 4) && rep)) {
        const int l15 = F.lane & 15, l4 = F.lane >> 4, w = F.wave;
        const bf16* wt = (const bf16*)(F.ws + WS_RWWT) + (size_t)lyr * 49152 + opaque0();
        const LAS unsigned char* lowp = (const LAS unsigned char*)LOWB + l15 * 400 + 16 * l4;
#pragma unroll 1
        for (int pq = 0; pq < 5; ++pq) {
            const int K = pq < 4 ? 32 : 64, colb = pq < 4 ? pq * 32 : 128;
            const bf16* wp = wt + (pq < 4 ? pq * 8192 : 32768);
            bf16* dst = rwarr(F, pq == 0 ? RA_EF : pq == 1 ? RA_EB : pq == 2 ? RA_AF : pq == 3 ? RA_AB : RA_G);
            if (RWP_VAR && rep) dst = (bf16*)(F.ws + WS_HO + (size_t)(pq & 3) * SZ_ROWS256);
            const float* bsrc = pq < 2 ? W.rw_w0 + pq * 256 : W.rw_a0 + (pq & 1) * 256;
            bf16x8 a0[2], a1[2]; f32x4 bias[2];
#pragma unroll
            for (int cbi = 0; cbi < 2; ++cbi) {
                const int chr = 32 * w + 8 * (l15 >> 2) + (l15 & 3) + 4 * cbi;
                a0[cbi] = *(const bf16x8*)(wp + (size_t)chr * K + 8 * l4);
                a1[cbi] = a0[cbi]; if (pq == 4) a1[cbi] = *(const bf16x8*)(wp + (size_t)chr * K + 32 + 8 * l4);
                bias[cbi] = (f32x4){0.f, 0.f, 0.f, 0.f}; if (pq < 4) bias[cbi] = *(const f32x4*)(bsrc + 32 * w + 8 * l4 + 4 * cbi);
            }
#pragma unroll
            for (int tb = 0; tb < 4; ++tb) {
                f32x4 acc[2];
#pragma unroll
                for (int cbi = 0; cbi < 2; ++cbi) {
                    acc[cbi] = bias[cbi];
                    acc[cbi] = __builtin_amdgcn_mfma_f32_16x16x32_bf16(a0[cbi], *(const LAS bf16x8*)(lowp + tb * 6400 + colb * 2), acc[cbi], 0, 0, 0);
                    if (pq == 4) acc[cbi] = __builtin_amdgcn_mfma_f32_16x16x32_bf16(a1[cbi], *(const LAS bf16x8*)(lowp + tb * 6400 + colb * 2 + 64), acc[cbi], 0, 0, 0);
                    if (pq < 4) { const float osc = pq < 2 ? 0.6065306597126334f : 1.0f;
#pragma unroll
                        for (int r = 0; r < 4; ++r) acc[cbi][r] = osc * fsigmoid(acc[cbi][r]); }
                }
                v4u o; o.x = cvtpk(acc[0][0], acc[0][1]); o.y = cvtpk(acc[0][2], acc[0][3]); o.z = cvtpk(acc[1][0], acc[1][1]); o.w = cvtpk(acc[1][2], acc[1][3]);
                *(v4u*)(dst + ((size_t)row0 + 16 * tb + l15) * 256 + 32 * w + 8 * l4) = o;
            }
        }
    }
    __syncthreads();
}

constexpr int GLA_WA_OFF = 131072 + 1024;
__device__ __forceinline__ void gla_stage_wa(Frame& F, const LayerW& W) {
    LAS bf16* wa = (LAS bf16*)(F.lds + GLA_WA_OFF); LAS float* ba = (LAS float*)(F.lds + GLA_WA_OFF + 8192);
    const float* src = W.gla_wa2 + opaque0();
    for (int q = F.tid; q < 4096; q += NTHREADS) wa[q] = (bf16)f2bf(src[q]);
    if (F.tid < 256) ba[F.tid] = (W.gla_ba + opaque0())[F.tid];
    __syncthreads();
}
__device__ __forceinline__ void gla_low_issue(Frame& F, int rowc0, v4u& w0, v4u& w1) {
    const int d = F.tid >> 8, i = (F.tid >> 2) & 63;
    const bf16* lt = ptile(F, PT_LOW) + (size_t)(rowc0 + i) * 256 + d * 16;
    w0 = *(const v4u*)lt; w1 = *(const v4u*)(lt + 8);
}
__device__ __forceinline__ void gla_decay_tables(Frame& F, const LayerW& W, int h, v4u w0, v4u w1, LAS float* CUM  ) {
    const int d = F.tid >> 8, i = (F.tid >> 2) & 63, cq = F.tid & 3;
    {
        const float al[16] = {bflo(w0.x), bfhi(w0.x), bflo(w0.y), bfhi(w0.y), bflo(w0.z), bfhi(w0.z), bflo(w0.w), bfhi(w0.w), bflo(w1.x), bfhi(w1.x), bflo(w1.y), bfhi(w1.y), bflo(w1.z), bfhi(w1.z), bflo(w1.w), bfhi(w1.w)};
        const LAS bf16* wp = (const LAS bf16*)(F.lds + GLA_WA_OFF) + d * 2048 + h * 32 + cq * 8;
        const LAS float* bp = (const LAS float*)(F.lds + GLA_WA_OFF + 8192) + d * 128 + h * 32 + cq * 8;
        f32x4 z0 = *(const LAS f32x4*)bp, z1 = *(const LAS f32x4*)(bp + 4);
#pragma unroll
        for (int r = 0; r < 16; ++r) { const v4u ww = *(const LAS v4u*)(wp + r * 128);
            z0 += (f32x4){bflo(ww.x), bfhi(ww.x), bflo(ww.y), bfhi(ww.y)} * al[r]; z1 += (f32x4){bflo(ww.z), bfhi(ww.z), bflo(ww.w), bfhi(ww.w)} * al[r]; }
        const float z[8] = {z0.x, z0.y, z0.z, z0.w, z1.x, z1.y, z1.z, z1.w};
#pragma unroll
        for (int e = 0; e < 8; ++e) { const float ls = fminf(z[e], 0.f) - __logf(1.0f + fexp(-fabsf(z[e])));
            CUM[(d * 64 + i) * 32 + cq * 8 + e] = ls * (1.0f / 16.0f); }
    }
    __syncthreads();
    {
        LAS float* TOT = CUM + 30208;
        const int seq = F.lane, d = seq >> 5, c = seq & 31, part = F.wave;
        float loc[8]; float run = 0.f;
#pragma unroll
        for (int k = 0; k < 8; ++k) { const int ip = part * 8 + k, i = d == 0 ? ip : 63 - ip; run += CUM[(d * 64 + i) * 32 + c]; loc[k] = run; }
        TOT[part * 64 + seq] = run;
        __syncthreads();
        float off = 0.f;
#pragma unroll
        for (int p = 0; p < 7; ++p) off += (p < part) ? TOT[p * 64 + seq] : 0.f;
#pragma unroll
        for (int k = 0; k < 8; ++k) { const int ip = part * 8 + k, i = d == 0 ? ip : 63 - ip; CUM[(d * 64 + i) * 32 + c] = loc[k] + off; }
    }
    __syncthreads();
}
__device__ __forceinline__ void gla_a_issue(Frame& F, int item, v4u& w0, v4u& w1, v4u& wk, v4u& wv) {
    const int bh = item / NCHUNK, c = item % NCHUNK, b = bh >> 2, h = bh & 3; const int rowc0 = chunk_row0(b, c);
    gla_low_issue(F, rowc0, w0, w1);
    const int j = (F.tid >> 2) & 63, cq = F.tid & 3;
    wk = *(const v4u*)(ptile(F, PT_GLA_QK) + (size_t)(rowc0 + j) * 256 + 128 + h * 32 + cq * 8);
    const int jv = F.tid >> 3, vq = F.tid & 7;
    wv = *(const v4u*)(ptile(F, PT_GLA_V) + (size_t)(rowc0 + jv) * 256 + h * 64 + vq * 8);
}
__device__ __forceinline__ void gla_a_item(Frame& F, const LayerW& W, int item, int nxt, int nitems, v4u& w0, v4u& w1, v4u& wk, v4u& wv) {
    const int bh = item / NCHUNK, c = item % NCHUNK, h = bh & 3;
    LAS float* CUM = (LAS float*)(F.lds + RING_OFF);
    LAS unsigned char* KWT = F.lds + RING_OFF + 16384;
    LAS unsigned char* VTT = KWT + 9216;
    {
        const int jv = F.tid >> 3, vq = F.tid & 7; const unsigned wvv[4] = {wv.x, wv.y, wv.z, wv.w};
#pragma unroll
        for (int e = 0; e < 8; ++e) *(LAS bf16*)(VTT + (vq * 8 + e) * 144 + jv * 2) = (bf16)((e & 1) ? (wvv[e >> 1] >> 16) : (wvv[e >> 1] & 0xffffu));
    }
    const v4u kw_ = wk, l0 = w0, l1 = w1;
    asm volatile("" ::: "memory");
    if (nxt < nitems) gla_a_issue(F, nxt, w0, w1, wk, wv);
    asm volatile("" ::: "memory");
    gla_decay_tables(F, W, h, l0, l1, CUM);
    {
        const int d = F.tid >> 8, j = (F.tid >> 2) & 63, cq = F.tid & 3;
        const float kv[8] = {bflo(kw_.x), bfhi(kw_.x), bflo(kw_.y), bfhi(kw_.y), bflo(kw_.z), bfhi(kw_.z), bflo(kw_.w), bfhi(kw_.w)};
#pragma unroll
        for (int e = 0; e < 8; ++e) { const int cc = cq * 8 + e; const float tot = d == 0 ? CUM[63 * 32 + cc] : CUM[64 * 32 + cc];
            const float val = kv[e] * fexp(tot - CUM[(d * 64 + j) * 32 + cc]); *(LAS bf16*)(KWT + (d * 32 + cc) * 144 + j * 2) = (bf16)(cvtpk(val, val) & 0xffffu); }
    }
    __syncthreads();
    {
        const int l15 = F.lane & 15, l4 = F.lane >> 4, d = F.wave >> 2, mb = F.wave & 3;
        f32x4 acc0 = (f32x4){0.f, 0.f, 0.f, 0.f}, acc1 = acc0;
#pragma unroll
        for (int ks = 0; ks < 2; ++ks) {
            const bf16x8 a = *(const LAS bf16x8*)(VTT + (16 * mb + l15) * 144 + ks * 64 + 16 * l4);
            const bf16x8 b0 = *(const LAS bf16x8*)(KWT + (d * 32 + l15) * 144 + ks * 64 + 16 * l4), b1 = *(const LAS bf16x8*)(KWT + (d * 32 + 16 + l15) * 144 + ks * 64 + 16 * l4);
            acc0 = __builtin_amdgcn_mfma_f32_16x16x32_bf16(a, b0, acc0, 0, 0, 0); acc1 = __builtin_amdgcn_mfma_f32_16x16x32_bf16(a, b1, acc1, 0, 0, 0);
        }
        float* gs = (float*)(F.ws + WS_GLAS) + ((size_t)(bh * 2 + d) * NCHUNK + c) * 2112 + 16 * mb + 4 * l4;
        *(f32x4*)(gs + l15 * 64) = acc0; *(f32x4*)(gs + (16 + l15) * 64) = acc1;
        if (F.tid < 64) { const int dd = F.tid >> 5, c2 = F.tid & 31; float* g2 = (float*)(F.ws + WS_GLAS) + ((size_t)(bh * 2 + dd) * NCHUNK + c) * 2112;
            g2[2048 + c2] = fexp(dd == 0 ? CUM[63 * 32 + c2] : CUM[64 * 32 + c2]); }
    }
    __syncthreads();
}
__device__ __forceinline__ void m1_prep(Frame& F, int l, int rep) {
    const LayerW W = layer_w(F, l);
#ifndef M1_PART
#define M1_PART 7
#endif
#ifndef M1REP_PART
#define M1REP_PART 6
#endif
    gla_stage_wa(F, W);
    if ((M1_PART & 1) && (rep == 0 || (M1REP_PART & 1))) { rope_stage(F); for (int it = F.vcu; it < NTILE64; it += F.G) attn_prep_tile(F, W, it, rep); }
    if (!RW_BASE_IN_TILE && (M1_PART & 2) && (rep == 0 || (M1REP_PART & 2)) && !((RWP_VAR & 2) && rep)) rwkv_base_stream(F, W);
    if ((M1_PART & 2) && (rep == 0 || (M1REP_PART & 2))) for (int it = F.G - 1 - F.vcu; it < NTILE64; it += F.G) rwkv_prep_tile(F, W, it, l, rep);
    if ((M1_PART & 4) && (rep == 0 || (M1REP_PART & 4))) {
        int it = (F.vcu + F.G - 32) % F.G; v4u w0, w1, wk, wv;
        if (it < 32 * NCHUNK) gla_a_issue(F, it, w0, w1, wk, wv);
        for (; it < 32 * NCHUNK; it += F.G) gla_a_item(F, W, it, it + F.G, 32 * NCHUNK, w0, w1, wk, wv);
    }
}

#define UNPK(q_) {bflo(q_.x), bfhi(q_.x), bflo(q_.y), bfhi(q_.y), bflo(q_.z), bfhi(q_.z), bflo(q_.w), bfhi(q_.w)}
__device__ __forceinline__ float fmax3(float a, float b, float c) { return __builtin_fmaxf(__builtin_fmaxf(a, b), c); }
struct AUnit { const bf16* Q; int hq0; const bf16* Kc; const bf16* Vt; const bf16* Vp; int vrow_lat, vrow_ctx; int a0, a1, b0, b1; int qpos0; float sink0, sink1; bf16* O; const float* qn; int qlat; };
#ifndef AT_RESCALE_THR
#define AT_RESCALE_THR 8.0f
#endif
constexpr int AT_KROW = 144, AT_VROW = ATT_VTR ? 192 : 144, AT_KT = 64 * AT_KROW, AT_VTB = 64 * AT_VROW, AT_BUF = AT_KT + AT_VTB;
template <bool SWA, int VAR = 0>
__device__ __forceinline__ void attn_unit(Frame& F, const AUnit& u) {
    const int lane = F.lane, r32 = lane & 31, hi = lane >> 5, wid = F.wave, hsel = wid >> 2, qrow = (wid & 3) * 32 + r32;
    const bool late = wid >= 4;
    LAS unsigned char* lds = F.lds + RING_OFF;
    constexpr int VB0 = 2 * AT_KT;
    bf16x8 qr[4];
    { const bf16* qp = u.Q + (size_t)qrow * 256 + (u.hq0 + hsel) * 64 + hi * 8;
#pragma unroll
      for (int d0 = 0; d0 < 4; ++d0) qr[d0] = *(const bf16x8*)(qp + d0 * 16); }
#if ATT_QPREP
    {
        float x[4][8];
#pragma unroll
        for (int d0 = 0; d0 < 4; ++d0) { const v4u w = __builtin_bit_cast(v4u, qr[d0]); x[d0][0] = bflo(w.x); x[d0][1] = bfhi(w.x); x[d0][2] = bflo(w.y); x[d0][3] = bfhi(w.y); x[d0][4] = bflo(w.z); x[d0][5] = bfhi(w.z); x[d0][6] = bflo(w.w); x[d0][7] = bfhi(w.w); }
        if (!SWA) {
            float ss = 0.f;
#pragma unroll
            for (int d0 = 0; d0 < 4; ++d0)
#pragma unroll
                for (int e = 0; e < 8; ++e) ss += x[d0][e] * x[d0][e];
            ss += __shfl_xor(ss, 32);
            const float rstd = __builtin_amdgcn_rsqf(ss * (1.0f / 64.0f) + NORM_EPS);
#pragma unroll
            for (int d0 = 0; d0 < 4; ++d0) { const float* gp = u.qn + d0 * 16 + hi * 8; const f32x4 g0 = *(const f32x4*)gp, g1 = *(const f32x4*)(gp + 4); const float g[8] = {g0.x, g0.y, g0.z, g0.w, g1.x, g1.y, g1.z, g1.w};
#pragma unroll
                for (int e = 0; e < 8; ++e) x[d0][e] = x[d0][e] * rstd * g[e]; }
        }
        if (u.qlat) {
            const int tq = u.qpos0 + qrow; const float* rope = (const float*)(F.ws + WS_ROPE);
#pragma unroll
            for (int hf = 0; hf < 2; ++hf) {
                const float* tp = (hf == 0 ? rope + (tq >> 6) * 32 : rope + 128 * 32 + (tq & 63) * 32) + hi * 16;
                const f32x4 c0 = *(const f32x4*)tp, c1 = *(const f32x4*)(tp + 4), c2 = *(const f32x4*)(tp + 8), c3 = *(const f32x4*)(tp + 12);
                const float cs[16] = {c0.x, c0.y, c0.z, c0.w, c1.x, c1.y, c1.z, c1.w, c2.x, c2.y, c2.z, c2.w, c3.x, c3.y, c3.z, c3.w};
#pragma unroll
                for (int e = 0; e < 8; ++e) { const float a = x[2 * hf][e], b = x[2 * hf + 1][e]; x[2 * hf][e] = a * cs[2 * e] - b * cs[2 * e + 1]; x[2 * hf + 1][e] = b * cs[2 * e] + a * cs[2 * e + 1]; }
            }
        }
#pragma unroll
        for (int d0 = 0; d0 < 4; ++d0) { const float sc_ = 0.125f * LOG2E; v4u w; w.x = cvtpk(x[d0][0] * sc_, x[d0][1] * sc_); w.y = cvtpk(x[d0][2] * sc_, x[d0][3] * sc_); w.z = cvtpk(x[d0][4] * sc_, x[d0][5] * sc_); w.w = cvtpk(x[d0][6] * sc_, x[d0][7] * sc_);
            qr[d0] = __builtin_bit_cast(bf16x8, w); }
    }
#endif
    float m = SWA ? (hsel ? u.sink1 : u.sink0) : 0.f; float lsum = (SWA && hi == 0) ? 1.0f : 0.0f;
    f32x16 o0, o1;
#pragma unroll
    for (int r = 0; r < 16; ++r) { o0[r] = 0.f; o1[r] = 0.f; }
    const int na = u.a1 - u.a0, nt = na + (u.b1 - u.b0);
    const int skey = F.tid >> 3, sch = F.tid & 7;
    const int vtr_base = (4 * hi + ((lane & 15) >> 2)) * AT_VROW + (16 * ((lane >> 4) & 1) + 4 * (lane & 3)) * 2;
    v4u kreg, vreg;
#define AT_LOAD(t) do { const int tile_ = (t) < na ? u.a0 + (t) : u.b0 + ((t) - na); kreg = *(const v4u*)(u.Kc + ((size_t)tile_ * 64 + skey) * 64 + sch * 8); \
        vreg = *(const v4u*)(u.Vt + ((size_t)tile_ * 64 + skey) * 64 + sch * 8); } while (0)
#define AT_STORE(kbuf, voff) do { *(LAS v4u*)(lds + (kbuf) * AT_KT + skey * AT_KROW + sch * 16) = kreg; \
        *(LAS v4u*)(lds + VB0 + (voff) + skey * AT_VROW + sch * 16) = vreg; } while (0)
#define AT_VREQ(voff) do { _Pragma("unroll") for (int db = 0; db < 2; ++db) _Pragma("unroll") for (int kq = 0; kq < 2; ++kq) _Pragma("unroll") for (int s2 = 0; s2 < 2; ++s2) { \
            typedef short s4v_ __attribute__((ext_vector_type(4))); \
            const LAS unsigned char* a_ = lds + VB0 + (voff) + vtr_base + (32 * kq + 16 * s2) * AT_VROW + 64 * db; \
            const s4v_ t0_ = __builtin_amdgcn_ds_read_tr16_b64_v4i16((LAS s4v_*)a_), t1_ = __builtin_amdgcn_ds_read_tr16_b64_v4i16((LAS s4v_*)(a_ + 8 * AT_VROW)); \
            const v2u u0_ = __builtin_bit_cast(v2u, t0_), u1_ = __builtin_bit_cast(v2u, t1_); vfr[db][kq][s2] = (v4u){u0_.x, u0_.y, u1_.x, u1_.y}; } } while (0)
#define AT_PVM(PF) do { _Pragma("unroll") for (int db = 0; db < 2; ++db) _Pragma("unroll") for (int kq = 0; kq < 2; ++kq) _Pragma("unroll") for (int s2 = 0; s2 < 2; ++s2) { \
            const bf16x8 vf = __builtin_bit_cast(bf16x8, vfr[db][kq][s2]); \
            if (db == 0) o0 = __builtin_amdgcn_mfma_f32_32x32x16_bf16(vf, PF[kq][s2], o0, 0, 0, 0); else o1 = __builtin_amdgcn_mfma_f32_32x32x16_bf16(vf, PF[kq][s2], o1, 0, 0, 0); } } while (0)
#define AT_QK(t, kb) do { const float nm = (!SWA && (t) == 0) ? 0.f : -m; \
        _Pragma("unroll") for (int r = 0; r < 16; ++r) { p0[r] = nm; p1[r] = nm; } \
        bf16x8 kf0[4], kf1[4]; \
        _Pragma("unroll") for (int d0 = 0; d0 < 4; ++d0) { kf0[d0] = *(const LAS bf16x8*)((kb) + r32 * AT_KROW + d0 * 32 + hi * 16); kf1[d0] = *(const LAS bf16x8*)((kb) + (32 + r32) * AT_KROW + d0 * 32 + hi * 16); } \
        __builtin_amdgcn_sched_barrier(0); \
        _Pragma("unroll") for (int d0 = 0; d0 < 4; ++d0) { p0 = __builtin_amdgcn_mfma_f32_32x32x16_bf16(kf0[d0], qr[d0], p0, 0, 0, 0); p1 = __builtin_amdgcn_mfma_f32_32x32x16_bf16(kf1[d0], qr[d0], p1, 0, 0, 0); } } while (0)
#define AT_SM(t, PF) do { const bool first = !SWA && (t) == 0; \
        if (SWA && (t) < na) { const int kbase = (u.a0 + (t)) * 64 + 4 * hi, qp = u.qpos0 + qrow; \
            _Pragma("unroll") for (int r = 0; r < 16; ++r) { const int kp = kbase + (r & 3) + 8 * (r >> 2); const int d0 = kp - qp, d1 = d0 + 32; \
                if (d0 > 128 || d0 < -128) p0[r] = -INFINITY; if (d1 > 128 || d1 < -128) p1[r] = -INFINITY; } } \
        float mx; { float a = fmax3(p0[0], p0[1], p1[0]), b = fmax3(p0[2], p0[3], p1[1]); a = fmax3(a, p1[2], p1[3]); \
          _Pragma("unroll") for (int r = 4; r < 16; r += 4) { a = fmax3(a, p0[r], p0[r + 1]); b = fmax3(b, p0[r + 2], p0[r + 3]); a = fmax3(a, p1[r], p1[r + 1]); b = fmax3(b, p1[r + 2], p1[r + 3]); } \
          mx = fmaxf(a, b); const auto rr = __builtin_amdgcn_permlane32_swap(__float_as_uint(mx), __float_as_uint(mx), false, false); mx = fmaxf(__uint_as_float(rr[0]), __uint_as_float(rr[1])); } \
        if (first || __builtin_amdgcn_ballot_w64(mx > AT_RESCALE_THR) != 0ull) { const float delta = first ? mx : fmaxf(mx, 0.f); const float alpha = first ? 0.f : fexp2(-delta); m += delta; lsum *= alpha; \
            _Pragma("unroll") for (int r = 0; r < 16; ++r) { p0[r] -= delta; p1[r] -= delta; o0[r] *= alpha; o1[r] *= alpha; } } \
        float rs = 0.f; _Pragma("unroll") for (int r = 0; r < 16; ++r) { p0[r] = fexp2(p0[r]); p1[r] = fexp2(p1[r]); rs += p0[r] + p1[r]; } lsum += rs; \
        _Pragma("unroll") for (int s = 0; s < 2; ++s) { v4u w0, w1; \
            w0.x = cvtpk(p0[8 * s + 0], p0[8 * s + 1]); w0.y = cvtpk(p0[8 * s + 2], p0[8 * s + 3]); w0.z = cvtpk(p0[8 * s + 4], p0[8 * s + 5]); w0.w = cvtpk(p0[8 * s + 6], p0[8 * s + 7]); \
            w1.x = cvtpk(p1[8 * s + 0], p1[8 * s + 1]); w1.y = cvtpk(p1[8 * s + 2], p1[8 * s + 3]); w1.z = cvtpk(p1[8 * s + 4], p1[8 * s + 5]); w1.w = cvtpk(p1[8 * s + 6], p1[8 * s + 7]); \
            PF[0][s] = __builtin_bit_cast(bf16x8, w0); PF[1][s] = __builtin_bit_cast(bf16x8, w1); } } while (0)
#define AT_TAIL(t) do { if ((t) + 1 < nt) AT_STORE(((t) + 1) & 1, vnext); \
        __syncthreads(); vprev = vcur; vcur = vnext; vnext = (vnext == 2 * AT_VTB) ? 0 : vnext + AT_VTB; } while (0)
    AT_LOAD(0); AT_STORE(0, 0); __syncthreads();
    int vprev = 0, vcur = 0, vnext = AT_VTB;
    f32x16 p0, p1; v4u vfr[2][2][2]; bf16x8 pf[2][2];
    if (!late) {
        for (int t = 0; t < nt; ++t) {
            if (t + 1 < nt) AT_LOAD(t + 1);
            AT_QK(t, lds + (t & 1) * AT_KT);
            AT_VREQ(vcur);
            __builtin_amdgcn_sched_barrier(0);
            AT_SM(t, pf);
            AT_PVM(pf);
            AT_TAIL(t);
        }
        __syncthreads();
    } else {
        for (int t = 0; t <= nt; ++t) {
            if (t + 1 < nt) AT_LOAD(t + 1);
            if (t < nt) AT_QK(t, lds + (t & 1) * AT_KT);
            if (t > 0) AT_VREQ(vprev);
            __builtin_amdgcn_sched_barrier(0);
            if (t > 0) AT_PVM(pf);
            if (t < nt) AT_SM(t, pf);
            AT_TAIL(t);
        }
    }
#undef AT_LOAD
#undef AT_STORE
#undef AT_VREQ
#undef AT_PVM
#undef AT_QK
#undef AT_SM
#undef AT_TAIL
    const float inv = 1.0f / (lsum + __shfl_xor(lsum, 32));
    bf16* op = u.O + (size_t)qrow * 1024 + (u.hq0 + hsel) * 64 + 4 * hi;
#pragma unroll
    for (int g = 0; g < 4; ++g) {
        v2u w; w.x = cvtpk(o0[4 * g] * inv, o0[4 * g + 1] * inv); w.y = cvtpk(o0[4 * g + 2] * inv, o0[4 * g + 3] * inv); *(v2u*)(op + 8 * g) = w;
        v2u x; x.x = cvtpk(o1[4 * g] * inv, o1[4 * g + 1] * inv); x.y = cvtpk(o1[4 * g + 2] * inv, o1[4 * g + 3] * inv); *(v2u*)(op + 32 + 8 * g) = x;
    }
}
constexpr int AT_VROW_T = 144, AT_VTB_T = 64 * AT_VROW_T;
template <bool SWA, int VAR = 0>
__device__ __forceinline__ void attn_unit_t(Frame& F, const AUnit& u) {
    const int lane = F.lane, r32 = lane & 31, hi = lane >> 5, wid = F.wave, hsel = wid >> 2, qrow = (wid & 3) * 32 + r32;
    const bool late = wid >= 4;
    LAS unsigned char* lds = F.lds + RING_OFF;
    constexpr int VB0 = 2 * AT_KT;
    bf16x8 qr[4];
    { const bf16* qp = u.Q + (size_t)qrow * 256 + (u.hq0 + hsel) * 64 + hi * 8;
#pragma unroll
      for (int d0 = 0; d0 < 4; ++d0) qr[d0] = *(const bf16x8*)(qp + d0 * 16); }
#if ATT_QPREP
    {
        float x[4][8];
#pragma unroll
        for (int d0 = 0; d0 < 4; ++d0) { const v4u w = __builtin_bit_cast(v4u, qr[d0]); x[d0][0] = bflo(w.x); x[d0][1] = bfhi(w.x); x[d0][2] = bflo(w.y); x[d0][3] = bfhi(w.y); x[d0][4] = bflo(w.z); x[d0][5] = bfhi(w.z); x[d0][6] = bflo(w.w); x[d0][7] = bfhi(w.w); }
        if (!SWA) {
            float ss = 0.f;
#pragma unroll
            for (int d0 = 0; d0 < 4; ++d0)
#pragma unroll
                for (int e = 0; e < 8; ++e) ss += x[d0][e] * x[d0][e];
            ss += __shfl_xor(ss, 32);
            const float rstd = __builtin_amdgcn_rsqf(ss * (1.0f / 64.0f) + NORM_EPS);
#pragma unroll
            for (int d0 = 0; d0 < 4; ++d0) { const float* gp = u.qn + d0 * 16 + hi * 8; const f32x4 g0 = *(const f32x4*)gp, g1 = *(const f32x4*)(gp + 4); const float g[8] = {g0.x, g0.y, g0.z, g0.w, g1.x, g1.y, g1.z, g1.w};
#pragma unroll
                for (int e = 0; e < 8; ++e) x[d0][e] = x[d0][e] * rstd * g[e]; }
        }
        if (u.qlat) {
            const int tq = u.qpos0 + qrow; const float* rope = (const float*)(F.ws + WS_ROPE);
#pragma unroll
            for (int hf = 0; hf < 2; ++hf) {
                const float* tp = (hf == 0 ? rope + (tq >> 6) * 32 : rope + 128 * 32 + (tq & 63) * 32) + hi * 16;
                const f32x4 c0 = *(const f32x4*)tp, c1 = *(const f32x4*)(tp + 4), c2 = *(const f32x4*)(tp + 8), c3 = *(const f32x4*)(tp + 12);
                const float cs[16] = {c0.x, c0.y, c0.z, c0.w, c1.x, c1.y, c1.z, c1.w, c2.x, c2.y, c2.z, c2.w, c3.x, c3.y, c3.z, c3.w};
#pragma unroll
                for (int e = 0; e < 8; ++e) { const float a = x[2 * hf][e], b = x[2 * hf + 1][e]; x[2 * hf][e] = a * cs[2 * e] - b * cs[2 * e + 1]; x[2 * hf + 1][e] = b * cs[2 * e] + a * cs[2 * e + 1]; }
            }
        }
#pragma unroll
        for (int d0 = 0; d0 < 4; ++d0) { const float sc_ = 0.125f * LOG2E; v4u w; w.x = cvtpk(x[d0][0] * sc_, x[d0][1] * sc_); w.y = cvtpk(x[d0][2] * sc_, x[d0][3] * sc_); w.z = cvtpk(x[d0][4] * sc_, x[d0][5] * sc_); w.w = cvtpk(x[d0][6] * sc_, x[d0][7] * sc_);
            qr[d0] = __builtin_bit_cast(bf16x8, w); }
    }
#endif
    float m = SWA ? (hsel ? u.sink1 : u.sink0) : 0.f; float lsum = (SWA && hi == 0) ? 1.0f : 0.0f;
    f32x16 o0, o1;
#pragma unroll
    for (int r = 0; r < 16; ++r) { o0[r] = 0.f; o1[r] = 0.f; }
    const int na = u.a1 - u.a0, nt = na + (u.b1 - u.b0);
    const int skey = F.tid >> 3, sch = F.tid & 7;
    v4u kreg, vreg;
#define AT_LOAD(t) do { const int tile_ = (t) < na ? u.a0 + (t) : u.b0 + ((t) - na); kreg = *(const v4u*)(u.Kc + ((size_t)tile_ * 64 + skey) * 64 + sch * 8); vreg = *(const v4u*)(u.Vt + (size_t)skey * NKEY + tile_ * 64 + sch * 8); } while (0)
#define AT_STORE(kbuf, voff) do { *(LAS v4u*)(lds + (kbuf) * AT_KT + skey * AT_KROW + sch * 16) = kreg; \
          \
        LAS unsigned char* vd_ = lds + VB0 + (voff) + skey * AT_VROW_T + (sch >> 1) * 32 + (sch & 1) * 8; \
        *(LAS v2u*)(vd_) = (v2u){vreg.x, vreg.y}; *(LAS v2u*)(vd_ + 16) = (v2u){vreg.z, vreg.w}; } while (0)
#define AT_VREQ(voff) do { _Pragma("unroll") for (int db = 0; db < 2; ++db) _Pragma("unroll") for (int kq = 0; kq < 2; ++kq) _Pragma("unroll") for (int s2 = 0; s2 < 2; ++s2) \
            vfr[db][kq][s2] = *(const LAS v4u*)(lds + VB0 + (voff) + (32 * db + r32) * AT_VROW_T + (32 * kq + 16 * s2 + 8 * hi) * 2); } while (0)
#define AT_PVM(PF) do { _Pragma("unroll") for (int db = 0; db < 2; ++db) _Pragma("unroll") for (int kq = 0; kq < 2; ++kq) _Pragma("unroll") for (int s2 = 0; s2 < 2; ++s2) { \
            const bf16x8 vf = __builtin_bit_cast(bf16x8, vfr[db][kq][s2]); \
            if (db == 0) o0 = __builtin_amdgcn_mfma_f32_32x32x16_bf16(vf, PF[kq][s2], o0, 0, 0, 0); else o1 = __builtin_amdgcn_mfma_f32_32x32x16_bf16(vf, PF[kq][s2], o1, 0, 0, 0); } } while (0)
#define AT_QK(t, kb) do { const float nm = (!SWA && (t) == 0) ? 0.f : -m; \
        _Pragma("unroll") for (int r = 0; r < 16; ++r) { p0[r] = nm; p1[r] = nm; } \
        bf16x8 kf0[4], kf1[4]; \
        _Pragma("unroll") for (int d0 = 0; d0 < 4; ++d0) { kf0[d0] = *(const LAS bf16x8*)((kb) + r32 * AT_KROW + d0 * 32 + hi * 16); kf1[d0] = *(const LAS bf16x8*)((kb) + (32 + r32) * AT_KROW + d0 * 32 + hi * 16); } \
        __builtin_amdgcn_sched_barrier(0); \
        _Pragma("unroll") for (int d0 = 0; d0 < 4; ++d0) { p0 = __builtin_amdgcn_mfma_f32_32x32x16_bf16(kf0[d0], qr[d0], p0, 0, 0, 0); p1 = __builtin_amdgcn_mfma_f32_32x32x16_bf16(kf1[d0], qr[d0], p1, 0, 0, 0); } } while (0)
#define AT_SM(t, PF) do { const bool first = !SWA && (t) == 0; \
        if (SWA && (t) < na) { const int kbase = (u.a0 + (t)) * 64 + 4 * hi, qp = u.qpos0 + qrow; \
            _Pragma("unroll") for (int r = 0; r < 16; ++r) { const int kp = kbase + (r & 3) + 8 * (r >> 2); const int d0 = kp - qp, d1 = d0 + 32; \
                if (d0 > 128 || d0 < -128) p0[r] = -INFINITY; if (d1 > 128 || d1 < -128) p1[r] = -INFINITY; } } \
        float mx; { float a = fmax3(p0[0], p0[1], p1[0]), b = fmax3(p0[2], p0[3], p1[1]); a = fmax3(a, p1[2], p1[3]); \
          _Pragma("unroll") for (int r = 4; r < 16; r += 4) { a = fmax3(a, p0[r], p0[r + 1]); b = fmax3(b, p0[r + 2], p0[r + 3]); a = fmax3(a, p1[r], p1[r + 1]); b = fmax3(b, p1[r + 2], p1[r + 3]); } \
          mx = fmaxf(a, b); const auto rr = __builtin_amdgcn_permlane32_swap(__float_as_uint(mx), __float_as_uint(mx), false, false); mx = fmaxf(__uint_as_float(rr[0]), __uint_as_float(rr[1])); } \
        if (first || __builtin_amdgcn_ballot_w64(mx > AT_RESCALE_THR) != 0ull) { const float delta = first ? mx : fmaxf(mx, 0.f); const float alpha = first ? 0.f : fexp2(-delta); m += delta; lsum *= alpha; \
            _Pragma("unroll") for (int r = 0; r < 16; ++r) { p0[r] -= delta; p1[r] -= delta; o0[r] *= alpha; o1[r] *= alpha; } } \
        float rs = 0.f; _Pragma("unroll") for (int r = 0; r < 16; ++r) { p0[r] = fexp2(p0[r]); p1[r] = fexp2(p1[r]); rs += p0[r] + p1[r]; } lsum += rs; \
        _Pragma("unroll") for (int s = 0; s < 2; ++s) { v4u w0, w1; \
            w0.x = cvtpk(p0[8 * s + 0], p0[8 * s + 1]); w0.y = cvtpk(p0[8 * s + 2], p0[8 * s + 3]); w0.z = cvtpk(p0[8 * s + 4], p0[8 * s + 5]); w0.w = cvtpk(p0[8 * s + 6], p0[8 * s + 7]); \
            w1.x = cvtpk(p1[8 * s + 0], p1[8 * s + 1]); w1.y = cvtpk(p1[8 * s + 2], p1[8 * s + 3]); w1.z = cvtpk(p1[8 * s + 4], p1[8 * s + 5]); w1.w = cvtpk(p1[8 * s + 6], p1[8 * s + 7]); \
            PF[0][s] = __builtin_bit_cast(bf16x8, w0); PF[1][s] = __builtin_bit_cast(bf16x8, w1); } } while (0)
#define AT_TAIL(t) do { if ((t) + 1 < nt) AT_STORE(((t) + 1) & 1, vnext); \
        __syncthreads(); vprev = vcur; vcur = vnext; vnext = (vnext == 2 * AT_VTB_T) ? 0 : vnext + AT_VTB_T; } while (0)
    AT_LOAD(0); AT_STORE(0, 0); __syncthreads();
    int vprev = 0, vcur = 0, vnext = AT_VTB_T;
    f32x16 p0, p1; v4u vfr[2][2][2]; bf16x8 pf[2][2];
    if (!late) {
        for (int t = 0; t < nt; ++t) {
            if (t + 1 < nt) AT_LOAD(t + 1);
            AT_QK(t, lds + (t & 1) * AT_KT);
            AT_VREQ(vcur);
            __builtin_amdgcn_sched_barrier(0);
            AT_SM(t, pf);
            AT_PVM(pf);
            AT_TAIL(t);
        }
        __syncthreads();
    } else {
        for (int t = 0; t <= nt; ++t) {
            if (t + 1 < nt) AT_LOAD(t + 1);
            if (t < nt) AT_QK(t, lds + (t & 1) * AT_KT);
            if (t > 0) AT_VREQ(vprev);
            __builtin_amdgcn_sched_barrier(0);
            if (t > 0) AT_PVM(pf);
            if (t < nt) AT_SM(t, pf);
            AT_TAIL(t);
        }
    }
#undef AT_LOAD
#undef AT_STORE
#undef AT_VREQ
#undef AT_PVM
#undef AT_QK
#undef AT_SM
#undef AT_TAIL
    const float inv = 1.0f / (lsum + __shfl_xor(lsum, 32));
    bf16* op = u.O + (size_t)qrow * 1024 + (u.hq0 + hsel) * 64 + 4 * hi;
#pragma unroll
    for (int g = 0; g < 4; ++g) {
        v2u w; w.x = cvtpk(o0[4 * g] * inv, o0[4 * g + 1] * inv); w.y = cvtpk(o0[4 * g + 2] * inv, o0[4 * g + 3] * inv); *(v2u*)(op + 8 * g) = w;
        v2u x; x.x = cvtpk(o1[4 * g] * inv, o1[4 * g + 1] * inv); x.y = cvtpk(o1[4 * g + 2] * inv, o1[4 * g + 3] * inv); *(v2u*)(op + 32 + 8 * g) = x;
    }
}
#ifndef ATT_PIPE
#define ATT_PIPE 0
#endif
template <bool SWA>
__device__ __forceinline__ void attn_unit_p(Frame& F, const AUnit& u) {
    const int lane = F.lane, r32 = lane & 31, hi = lane >> 5, wid = F.wave, hsel = wid >> 2, qrow = (wid & 3) * 32 + r32;
    LAS unsigned char* lds = F.lds + RING_OFF;
    constexpr int VB0 = 3 * AT_KT;
    bf16x8 qr[4];
    { const bf16* qp = u.Q + (size_t)qrow * 256 + (u.hq0 + hsel) * 64 + hi * 8;
#pragma unroll
      for (int d0 = 0; d0 < 4; ++d0) qr[d0] = *(const bf16x8*)(qp + d0 * 16); }
    float m = SWA ? (hsel ? u.sink1 : u.sink0) : 0.f; float lsum = (SWA && hi == 0) ? 1.0f : 0.0f;
    f32x16 o0, o1;
#pragma unroll
    for (int r = 0; r < 16; ++r) { o0[r] = 0.f; o1[r] = 0.f; }
    const int na = u.a1 - u.a0, nt = na + (u.b1 - u.b0);
    const int skey = F.tid >> 3, sch = F.tid & 7;
    v4u kreg, vreg;
#define PL_TILE(t) ((t) < na ? u.a0 + (t) : u.b0 + ((t) - na))
#define PL_LOADK(t) do { kreg = *(const v4u*)(u.Kc + ((size_t)PL_TILE(t) * 64 + skey) * 64 + sch * 8); } while (0)
#define PL_LOADV(t) do { vreg = *(const v4u*)(u.Vt + (size_t)skey * NKEY + PL_TILE(t) * 64 + sch * 8); } while (0)
#define PL_STOREK(koff) do { *(LAS v4u*)(lds + (koff) + skey * AT_KROW + sch * 16) = kreg; } while (0)
#define PL_STOREV(voff) do { LAS unsigned char* vd_ = lds + VB0 + (voff) + skey * AT_VROW + (sch >> 1) * 32 + (sch & 1) * 8; \
        *(LAS v2u*)(vd_) = (v2u){vreg.x, vreg.y}; *(LAS v2u*)(vd_ + 16) = (v2u){vreg.z, vreg.w}; } while (0)
#define PL_QK(P0, P1, koff, nm_) do { _Pragma("unroll") for (int r = 0; r < 16; ++r) { P0[r] = (nm_); P1[r] = (nm_); } \
        _Pragma("unroll") for (int d0 = 0; d0 < 4; ++d0) { \
            const bf16x8 k0_ = *(const LAS bf16x8*)(lds + (koff) + r32 * AT_KROW + d0 * 32 + hi * 16), k1_ = *(const LAS bf16x8*)(lds + (koff) + (32 + r32) * AT_KROW + d0 * 32 + hi * 16); \
            P0 = __builtin_amdgcn_mfma_f32_32x32x16_bf16(k0_, qr[d0], P0, 0, 0, 0); P1 = __builtin_amdgcn_mfma_f32_32x32x16_bf16(k1_, qr[d0], P1, 0, 0, 0); } } while (0)
#define PL_EXP4(CX, base_, W_) do { CX[base_] = fexp2(CX[base_]); CX[base_ + 1] = fexp2(CX[base_ + 1]); CX[base_ + 2] = fexp2(CX[base_ + 2]); CX[base_ + 3] = fexp2(CX[base_ + 3]); \
        rs += (CX[base_] + CX[base_ + 1]) + (CX[base_ + 2] + CX[base_ + 3]); W_[((base_) >> 1) & 3] = cvtpk(CX[base_], CX[base_ + 1]); W_[(((base_) >> 1) & 3) + 1] = cvtpk(CX[base_ + 2], CX[base_ + 3]); } while (0)
#define PL_MAX(tt_, P0, P1) do { \
        if (SWA && (tt_) < na) { const int kbase = (u.a0 + (tt_)) * 64 + 4 * hi, qp = u.qpos0 + qrow; \
            _Pragma("unroll") for (int r = 0; r < 16; ++r) { const int kp = kbase + (r & 3) + 8 * (r >> 2); const int d0 = kp - qp, d1 = d0 + 32; \
                if (d0 > 128 || d0 < -128) P0[r] = -INFINITY; if (d1 > 128 || d1 < -128) P1[r] = -INFINITY; } } \
        { float a = fmax3(P0[0], P0[1], P1[0]), b = fmax3(P0[2], P0[3], P1[1]); a = fmax3(a, P1[2], P1[3]); \
          _Pragma("unroll") for (int r = 4; r < 16; r += 4) { a = fmax3(a, P0[r], P0[r + 1]); b = fmax3(b, P0[r + 2], P0[r + 3]); a = fmax3(a, P1[r], P1[r + 1]); b = fmax3(b, P1[r + 2], P1[r + 3]); } \
          mx = fmaxf(a, b); const auto rr = __builtin_amdgcn_permlane32_swap(__float_as_uint(mx), __float_as_uint(mx), false, false); mx = fmaxf(__uint_as_float(rr[0]), __uint_as_float(rr[1])); } } while (0)
#define PL_BODY(t, C0, C1, N0, N1) do { \
        if ((t) + 2 < nt) PL_LOADK((t) + 2); if ((t) + 1 < nt) PL_LOADV((t) + 1); \
        bf16x8 kf0[4], kf1[4]; \
        _Pragma("unroll") for (int d0 = 0; d0 < 4; ++d0) { kf0[d0] = *(const LAS bf16x8*)(lds + knext + r32 * AT_KROW + d0 * 32 + hi * 16); kf1[d0] = *(const LAS bf16x8*)(lds + knext + (32 + r32) * AT_KROW + d0 * 32 + hi * 16); } \
          \
        const bool first = !SWA && (t) == 0; \
        if (first || __builtin_amdgcn_ballot_w64(mx > AT_RESCALE_THR) != 0ull) { const float delta = first ? mx : fmaxf(mx, 0.f); const float alpha = first ? 0.f : fexp2(-delta); m += delta; lsum *= alpha; \
            _Pragma("unroll") for (int r = 0; r < 16; ++r) { C0[r] -= delta; C1[r] -= delta; o0[r] *= alpha; o1[r] *= alpha; } } \
          \
        _Pragma("unroll") for (int db = 0; db < 2; ++db) _Pragma("unroll") for (int kq = 0; kq < 2; ++kq) _Pragma("unroll") for (int s2 = 0; s2 < 2; ++s2) \
            vfr[db][kq][s2] = *(const LAS v4u*)(lds + VB0 + vcur + (32 * db + r32) * AT_VROW + (32 * kq + 16 * s2 + 8 * hi) * 2); \
          \
        { const float nm = -m; float rs = 0.f; unsigned w0[8], w1[8]; \
          _Pragma("unroll") for (int r = 0; r < 16; ++r) { N0[r] = nm; N1[r] = nm; } \
          __builtin_amdgcn_sched_barrier(0); \
          _Pragma("unroll") for (int d0 = 0; d0 < 4; ++d0) { \
            N0 = __builtin_amdgcn_mfma_f32_32x32x16_bf16(kf0[d0], qr[d0], N0, 0, 0, 0); \
            { unsigned* wq_ = w0 + 4 * (d0 >> 1); PL_EXP4(C0, 4 * d0, wq_); } \
            N1 = __builtin_amdgcn_mfma_f32_32x32x16_bf16(kf1[d0], qr[d0], N1, 0, 0, 0); \
            { unsigned* wq_ = w1 + 4 * (d0 >> 1); PL_EXP4(C1, 4 * d0, wq_); } } \
          _Pragma("unroll") for (int g_ = 0; g_ < 8; ++g_) { __builtin_amdgcn_sched_group_barrier(0x008, 1, 0); __builtin_amdgcn_sched_group_barrier(0x400, 4, 0); __builtin_amdgcn_sched_group_barrier(0x002, 5, 0); } \
          lsum += rs; \
          pf[0][0] = __builtin_bit_cast(bf16x8, (v4u){w0[0], w0[1], w0[2], w0[3]}); pf[0][1] = __builtin_bit_cast(bf16x8, (v4u){w0[4], w0[5], w0[6], w0[7]}); \
          pf[1][0] = __builtin_bit_cast(bf16x8, (v4u){w1[0], w1[1], w1[2], w1[3]}); pf[1][1] = __builtin_bit_cast(bf16x8, (v4u){w1[4], w1[5], w1[6], w1[7]}); } \
        __builtin_amdgcn_sched_barrier(0); \
          \
        _Pragma("unroll") for (int kq = 0; kq < 2; ++kq) _Pragma("unroll") for (int s2 = 0; s2 < 2; ++s2) { \
            o0 = __builtin_amdgcn_mfma_f32_32x32x16_bf16(__builtin_bit_cast(bf16x8, vfr[0][kq][s2]), pf[kq][s2], o0, 0, 0, 0); \
            o1 = __builtin_amdgcn_mfma_f32_32x32x16_bf16(__builtin_bit_cast(bf16x8, vfr[1][kq][s2]), pf[kq][s2], o1, 0, 0, 0); } \
        PL_MAX((t) + 1, N0, N1); \
        _Pragma("unroll") for (int g_ = 0; g_ < 8; ++g_) { __builtin_amdgcn_sched_group_barrier(0x008, 1, 1); __builtin_amdgcn_sched_group_barrier(0x002, 3, 1); } \
          \
        if ((t) + 2 < nt) PL_STOREK(knext2); if ((t) + 1 < nt) PL_STOREV(vcur ^ AT_VTB); \
        __syncthreads(); \
        { const int k_ = kcur; kcur = knext; knext = knext2; knext2 = k_; vcur ^= AT_VTB; } } while (0)
    PL_LOADK(0); PL_LOADV(0); PL_STOREK(0); PL_STOREV(0);
    if (nt > 1) { PL_LOADK(1); PL_STOREK(AT_KT); }
    __syncthreads();
    int kcur = 0, knext = AT_KT, knext2 = 2 * AT_KT, vcur = 0;
    f32x16 pa0, pa1, pb0, pb1; v4u vfr[2][2][2]; bf16x8 pf[2][2];
    float mx;
    { const float nm0 = SWA ? -m : 0.f; PL_QK(pa0, pa1, kcur, nm0); PL_MAX(0, pa0, pa1); }
    for (int t = 0; t < nt; t += 2) {
        PL_BODY(t, pa0, pa1, pb0, pb1);
        if (t + 1 < nt) PL_BODY(t + 1, pb0, pb1, pa0, pa1);
    }
    (void)kcur;
#undef PL_TILE
#undef PL_LOADK
#undef PL_LOADV
#undef PL_STOREK
#undef PL_STOREV
#undef PL_QK
#undef PL_EXP4
#undef PL_MAX
#undef PL_BODY
    const float inv = 1.0f / (lsum + __shfl_xor(lsum, 32));
    bf16* op = u.O + (size_t)qrow * 1024 + (u.hq0 + hsel) * 64 + 4 * hi;
#pragma unroll
    for (int g = 0; g < 4; ++g) {
        v2u w; w.x = cvtpk(o0[4 * g] * inv, o0[4 * g + 1] * inv); w.y = cvtpk(o0[4 * g + 2] * inv, o0[4 * g + 3] * inv); *(v2u*)(op + 8 * g) = w;
        v2u x; x.x = cvtpk(o1[4 * g] * inv, o1[4 * g + 1] * inv); x.y = cvtpk(o1[4 * g + 2] * inv, o1[4 * g + 3] * inv); *(v2u*)(op + 32 + 8 * g) = x;
    }
}

#ifndef ATT_PROBE_VAR
#define ATT_PROBE_VAR 0
#endif
__device__ __forceinline__ void attn_item(Frame& F, const LayerW& W, int kind, int uidx, int probe = 0) {
    const bool swa = kind >= 2, ctxq = kind & 1; const int mix = swa ? 0 : 1;
    const int qb = ctxq ? (uidx & 1) : (uidx & 63), bk = ctxq ? (uidx >> 1) : (uidx >> 6), b = bk >> 1, kvh = bk & 1;
    AUnit u;
    const size_t qrow0 = ctxq ? (size_t)M_LAT + b * CTXL + qb * 128 : (size_t)b * SEQ + qb * 128;
    u.Q = ptile(F, swa ? PT_SWA_Q : PT_FA_Q) + qrow0 * 256; u.hq0 = 2 * kvh;
    u.Kc = (const bf16*)(F.ws + WS_KC) + (size_t)((b * 2 + mix) * 2 + kvh) * NKEY * 64; u.Vt = (const bf16*)(F.ws + WS_VT) + (size_t)((b * 2 + mix) * 2 + kvh) * NKEY * 64;
    u.qn = W.fa_qn; u.qlat = ctxq ? 0 : 1; u.Vp = ptile(F, mix ? PT_FA_KV : PT_SWA_KV) + 128 + kvh * 64; u.vrow_lat = b * SEQ; u.vrow_ctx = M_LAT + b * CTXL - 128 * 64;
    u.qpos0 = qb * 128; u.sink0 = W.swa_sink[2 * kvh] * LOG2E; u.sink1 = W.swa_sink[2 * kvh + 1] * LOG2E;
    u.O = (bf16*)(F.ws + WS_HO) + qrow0 * 1024 + (swa ? 256 : 512);
    if (ctxq) { u.a0 = 0; u.a1 = 0; u.b0 = 128; u.b1 = 132; }
    else if (swa) { u.a0 = max(0, 2 * qb - 2); u.a1 = min(128, 2 * qb + 4); u.b0 = 128; u.b1 = 132; }
    else { u.a0 = 0; u.a1 = 0; u.b0 = 0; u.b1 = 132; }
    if (ATT_PROBE_VAR && probe) { u.O = ptile(F, PT_RW_V) + (qrow0 & 16383) * 1024 + (swa ? 256 : 512);
        if (swa) attn_unit<true, ATT_PROBE_VAR>(F, u); else attn_unit<false, ATT_PROBE_VAR>(F, u); return; }
#if ATT_PIPE
    if (swa) attn_unit_p<true>(F, u); else attn_unit_p<false>(F, u);
#else
#if ATT_VTR
    if (swa) attn_unit<true>(F, u); else attn_unit<false>(F, u);
#else
    if (swa) attn_unit_t<true>(F, u); else attn_unit_t<false>(F, u);
#endif
#endif
}

__device__ __forceinline__ float dpp_add(float v, float w) { return v + w; }
constexpr int RW_TC = 32, RW_VSZ = RW_TC * 384;
__device__ __forceinline__ void rwkv_scan_item(Frame& F, const LayerW& W, int item) {
    const int half = item & 1, dir = (item >> 1) & 1, bh = item >> 2, b = bh >> 2, h = bh & 3;
    LAS float* VEC = (LAS float*)(F.lds + RING_OFF);
    LAS float* YB = VEC + 2 * RW_VSZ;
    bf16* yout = ptile(F, dir ? PT_RW_K : PT_RW_R);
    constexpr int NCH = NKEY / RW_TC;
#define RW_ROW(ci, st) (chunk_row0(b, scan_chunk(dir, (ci) >> 1)) + (dir ? 63 - (((ci) & 1) * 32 + (st)) : ((ci) & 1) * 32 + (st)))
    if (F.wave >= 4) {
        const bf16 *aR = rwarr(F, RA_R), *aV = rwarr(F, RA_V), *aK = rwarr(F, RA_K), *aN = rwarr(F, RA_NKK), *aA = rwarr(F, dir ? RA_AB : RA_AF), *aE = rwarr(F, dir ? RA_EB : RA_EF);
        const int t = F.tid - 256, st = t >> 3, cg = t & 7;
        float ka[8];
        { const float* kap = W.rw_ka + h * 64 + cg * 8 + opaque0();
#pragma unroll
          for (int e = 0; e < 8; ++e) ka[e] = kap[e]; }
        for (int ci = -1; ci < NCH; ++ci) {
            if (ci + 1 < NCH) {
                const size_t off = (size_t)RW_ROW(ci + 1, st) * 256 + h * 64 + cg * 8;
                const v4u gR = *(const v4u*)(aR + off), gV = *(const v4u*)(aV + off), gK = *(const v4u*)(aK + off), gN = *(const v4u*)(aN + off), gA = *(const v4u*)(aA + off), gE = *(const v4u*)(aE + off);
                const float r[8] = UNPK(gR), v[8] = UNPK(gV), k[8] = UNPK(gK), n[8] = UNPK(gN), a[8] = UNPK(gA), E[8] = UNPK(gE);
                LAS float* vp = VEC + ((ci + 1) & 1) * RW_VSZ + st * 384 + cg * 8;
                float dc[8], bb[8], kd[8];
#pragma unroll
                for (int e = 0; e < 8; ++e) { dc[e] = fexp(-E[e]); bb[e] = -n[e] * a[e]; kd[e] = k[e] * (1.0f + (a[e] - 1.0f) * ka[e]); }
                *(LAS f32x4*)(vp) = (f32x4){n[0], n[1], n[2], n[3]}; *(LAS f32x4*)(vp + 4) = (f32x4){n[4], n[5], n[6], n[7]};
                *(LAS f32x4*)(vp + 64) = (f32x4){dc[0], dc[1], dc[2], dc[3]}; *(LAS f32x4*)(vp + 68) = (f32x4){dc[4], dc[5], dc[6], dc[7]};
                *(LAS f32x4*)(vp + 128) = (f32x4){bb[0], bb[1], bb[2], bb[3]}; *(LAS f32x4*)(vp + 132) = (f32x4){bb[4], bb[5], bb[6], bb[7]};
                *(LAS f32x4*)(vp + 192) = (f32x4){kd[0], kd[1], kd[2], kd[3]}; *(LAS f32x4*)(vp + 196) = (f32x4){kd[4], kd[5], kd[6], kd[7]};
                *(LAS f32x4*)(vp + 256) = (f32x4){r[0], r[1], r[2], r[3]}; *(LAS f32x4*)(vp + 260) = (f32x4){r[4], r[5], r[6], r[7]};
                *(LAS f32x4*)(vp + 320) = (f32x4){v[0], v[1], v[2], v[3]}; *(LAS f32x4*)(vp + 324) = (f32x4){v[4], v[5], v[6], v[7]};
            }
            if (ci >= 1) {
                const LAS float* yp = YB + ((ci - 1) & 1) * (RW_TC * 32) + st * 32 + cg * 4; const f32x4 y = *(const LAS f32x4*)yp;
                v2u w; w.x = cvtpk(y.x, y.y); w.y = cvtpk(y.z, y.w);
                *(v2u*)(yout + (size_t)RW_ROW(ci - 1, st) * 256 + h * 64 + half * 32 + cg * 4) = w;
            }
            __syncthreads();
        }
        {
            const int ci = NCH; const LAS float* yp = YB + ((ci - 1) & 1) * (RW_TC * 32) + st * 32 + cg * 4; const f32x4 y = *(const LAS f32x4*)yp;
            v2u w; w.x = cvtpk(y.x, y.y); w.y = cvtpk(y.z, y.w);
            *(v2u*)(yout + (size_t)RW_ROW(ci - 1, st) * 256 + h * 64 + half * 32 + cg * 4) = w;
        }
    } else {
        typedef float f32x2 __attribute__((ext_vector_type(2)));
        const int i = F.wave * 8 + (F.lane >> 3), j = F.lane & 7;
        const float z0 = __int_as_float(opaque0());
        f32x2 S0 = (f32x2){z0, z0}, S1 = S0, S2 = S0, S3 = S0;
        __syncthreads();
#define RW_LDV(s_) do { const LAS float* vp_ = vb + (s_) * 384; n0 = *(const LAS f32x4*)(vp_); n1 = *(const LAS f32x4*)(vp_ + 4); d0 = *(const LAS f32x4*)(vp_ + 64); d1 = *(const LAS f32x4*)(vp_ + 68); \
        b0 = *(const LAS f32x4*)(vp_ + 128); b1 = *(const LAS f32x4*)(vp_ + 132); k0 = *(const LAS f32x4*)(vp_ + 192); k1 = *(const LAS f32x4*)(vp_ + 196); \
        r0 = *(const LAS f32x4*)(vp_ + 256); r1 = *(const LAS f32x4*)(vp_ + 260); vv = vvp[(s_) * 384]; } while (0)
        for (int ci = 0; ci < NCH; ++ci) {
            const LAS float* vb = VEC + (ci & 1) * RW_VSZ + 8 * j; const LAS float* vvp = VEC + (ci & 1) * RW_VSZ + 320 + half * 32 + i;
            LAS float* yb = YB + (ci & 1) * (RW_TC * 32) + i;
            f32x4 n0, n1, d0, d1, b0, b1, k0, k1, r0, r1; float vv;
            RW_LDV(0);
#pragma unroll 2
            for (int s = 0; s < RW_TC; ++s) {
                const f32x4 cn0 = n0, cn1 = n1, cd0 = d0, cd1 = d1, cb0 = b0, cb1 = b1, ck0 = k0, ck1 = k1, cr0 = r0, cr1 = r1; const float cvv = vv;
                RW_LDV(s + 1 < RW_TC ? s + 1 : s);
                f32x2 p = S0 * cn0.lo; p = __builtin_elementwise_fma(S1, cn0.hi, p); p = __builtin_elementwise_fma(S2, cn1.lo, p); p = __builtin_elementwise_fma(S3, cn1.hi, p);
                const float sa = red8_dpp(p.x + p.y);
                const f32x2 sa2 = (f32x2){sa, sa}, vv2 = (f32x2){cvv, cvv};
                S0 = __builtin_elementwise_fma(S0, cd0.lo, __builtin_elementwise_fma(ck0.lo, vv2, cb0.lo * sa2));
                S1 = __builtin_elementwise_fma(S1, cd0.hi, __builtin_elementwise_fma(ck0.hi, vv2, cb0.hi * sa2));
                S2 = __builtin_elementwise_fma(S2, cd1.lo, __builtin_elementwise_fma(ck1.lo, vv2, cb1.lo * sa2));
                S3 = __builtin_elementwise_fma(S3, cd1.hi, __builtin_elementwise_fma(ck1.hi, vv2, cb1.hi * sa2));
                f32x2 q = S0 * cr0.lo; q = __builtin_elementwise_fma(S1, cr0.hi, q); q = __builtin_elementwise_fma(S2, cr1.lo, q); q = __builtin_elementwise_fma(S3, cr1.hi, q);
                yb[s * 32] = red8_dpp(q.x + q.y);
            }
            __syncthreads();
        }
#undef RW_LDV
    }
#undef RW_ROW
    __syncthreads();
}
__device__ __forceinline__ void gla_b_item(Frame& F, int item) {
    const int dir = item & 1, bh = item >> 1;
    float* base = (float*)(F.ws + WS_GLAS) + (size_t)(bh * 2 + dir) * NCHUNK * 2112;
    const int e0 = F.tid * 4, cc = e0 >> 6;
    const float z0 = __int_as_float(opaque0());
    f32x4 S = (f32x4){z0, z0, z0, z0};
    f32x4 kvA[4], kvB[4]; float dcA[4], dcB[4];
#define GB_LOAD(KV, DC, c4_) do { _Pragma("unroll") for (int q = 0; q < 4; ++q) { const float* p_ = base + (size_t)scan_chunk(dir, (c4_) + q) * 2112; KV[q] = *(const f32x4*)(p_ + e0); DC[q] = p_[2048 + cc]; } } while (0)
#define GB_STEP(KV, DC, c4_) do { _Pragma("unroll") for (int q = 0; q < 4; ++q) { float* p_ = base + (size_t)scan_chunk(dir, (c4_) + q) * 2112; *(f32x4*)(p_ + e0) = S; S = S * DC[q] + KV[q]; } } while (0)
    GB_LOAD(kvA, dcA, 0);
#pragma unroll 1
    for (int c4 = 0; c4 < NCHUNK; c4 += 8) {
        if (c4 + 4 < NCHUNK) GB_LOAD(kvB, dcB, c4 + 4);
        GB_STEP(kvA, dcA, c4);
        if (c4 + 4 < NCHUNK) { if (c4 + 8 < NCHUNK) GB_LOAD(kvA, dcA, c4 + 8); GB_STEP(kvB, dcB, c4 + 4); }
    }
#undef GB_LOAD
#undef GB_STEP
}

namespace rwc {
constexpr int ROWB = 144, MSZ = 64 * ROWB;
typedef float f32x4_t __attribute__((ext_vector_type(4)));
__device__ __forceinline__ bf16x8 frag(const LAS unsigned char* buf, int blk, int ks, int lane) { return *(const LAS bf16x8*)(buf + (blk * 16 + (lane & 15)) * ROWB + (ks * 32 + 8 * (lane >> 4)) * 2); }
__device__ __forceinline__ void mm2(f32x4 (&acc)[2], const LAS unsigned char* A, const LAS unsigned char* Bt, int mb, int nb0, int lane) {
    const bf16x8 a0 = frag(A, mb, 0, lane), a1 = frag(A, mb, 1, lane);
#pragma unroll
    for (int j = 0; j < 2; ++j) { const bf16x8 b0 = frag(Bt, nb0 + j, 0, lane), b1 = frag(Bt, nb0 + j, 1, lane);
        acc[j] = __builtin_amdgcn_mfma_f32_16x16x32_bf16(a0, b0, acc[j], 0, 0, 0); acc[j] = __builtin_amdgcn_mfma_f32_16x16x32_bf16(a1, b1, acc[j], 0, 0, 0); }
}
__device__ __forceinline__ void st_row(LAS unsigned char* buf, const f32x4 (&acc)[2], int mb, int nb0, int lane) {
#pragma unroll
    for (int j = 0; j < 2; ++j)
#pragma unroll
        for (int r = 0; r < 4; ++r) *(LAS bf16*)(buf + (16 * mb + 4 * (lane >> 4) + r) * ROWB + (16 * (nb0 + j) + (lane & 15)) * 2) = (bf16)(cvtpk(acc[j][r], 0.f) & 0xffffu);
}
__device__ __forceinline__ void st_tr(LAS unsigned char* buf, const f32x4 (&acc)[2], int mb, int nb0, int lane) {
#pragma unroll
    for (int j = 0; j < 2; ++j) { v2u w; w.x = cvtpk(acc[j][0], acc[j][1]); w.y = cvtpk(acc[j][2], acc[j][3]);
        *(LAS v2u*)(buf + (16 * (nb0 + j) + (lane & 15)) * ROWB + (16 * mb + 4 * (lane >> 4)) * 2) = w; }
}
__device__ __forceinline__ void mmb(f32x4& acc, const LAS unsigned char* Aa, const LAS unsigned char* Ba) {
    const bf16x8 a0 = *(const LAS bf16x8*)Aa, a1 = *(const LAS bf16x8*)(Aa + 64), b0 = *(const LAS bf16x8*)Ba, b1 = *(const LAS bf16x8*)(Ba + 64);
    acc = __builtin_amdgcn_mfma_f32_16x16x32_bf16(a0, b0, acc, 0, 0, 0); acc = __builtin_amdgcn_mfma_f32_16x16x32_bf16(a1, b1, acc, 0, 0, 0);
}
__device__ __forceinline__ void mmp(f32x4 (&acc)[2], const LAS unsigned char* Aa, const LAS unsigned char* Ba) {
    const bf16x8 a0 = *(const LAS bf16x8*)Aa, a1 = *(const LAS bf16x8*)(Aa + 64);
#pragma unroll
    for (int j = 0; j < 2; ++j) { const bf16x8 b0 = *(const LAS bf16x8*)(Ba + j * 16 * ROWB), b1 = *(const LAS bf16x8*)(Ba + j * 16 * ROWB + 64);
        acc[j] = __builtin_amdgcn_mfma_f32_16x16x32_bf16(a0, b0, acc[j], 0, 0, 0); acc[j] = __builtin_amdgcn_mfma_f32_16x16x32_bf16(a1, b1, acc[j], 0, 0, 0); }
}
__device__ __forceinline__ void stb_row(LAS unsigned char* Sr, const f32x4& a) { const unsigned w0 = cvtpk(a[0], a[1]), w1 = cvtpk(a[2], a[3]);
    *(LAS bf16*)(Sr) = (bf16)(w0 & 0xffffu); *(LAS bf16*)(Sr + ROWB) = (bf16)(w0 >> 16); *(LAS bf16*)(Sr + 2 * ROWB) = (bf16)(w1 & 0xffffu); *(LAS bf16*)(Sr + 3 * ROWB) = (bf16)(w1 >> 16); }
__device__ __forceinline__ void stb_tr(LAS unsigned char* St, const f32x4& a) { v2u w; w.x = cvtpk(a[0], a[1]); w.y = cvtpk(a[2], a[3]); *(LAS v2u*)St = w; }
__device__ __forceinline__ void mm1(f32x4& acc, const LAS unsigned char* A, const LAS unsigned char* Bt, int mb, int nb, int lane) {
    acc = __builtin_amdgcn_mfma_f32_16x16x32_bf16(frag(A, mb, 0, lane), frag(Bt, nb, 0, lane), acc, 0, 0, 0); acc = __builtin_amdgcn_mfma_f32_16x16x32_bf16(frag(A, mb, 1, lane), frag(Bt, nb, 1, lane), acc, 0, 0, 0);
}
typedef short s16x4 __attribute__((ext_vector_type(4)));
__device__ __forceinline__ s16x4 op16(const f32x4& x) { v2u w; w.x = cvtpk(x[0], x[1]); w.y = cvtpk(x[2], x[3]); return __builtin_bit_cast(s16x4, w); }
__device__ __forceinline__ f32x4 mf16(s16x4 a, s16x4 b, f32x4 c) { return __builtin_amdgcn_mfma_f32_16x16x16bf16_1k(a, b, c, 0, 0, 0); }
}

__device__ __forceinline__ void rwkv_chunk_item(Frame& F, const LayerW& W, int item) {
    using namespace rwc;
    const int dir = item & 1, bh = item >> 1, b = bh >> 2, h = bh & 3;
    const int w = F.wave, mb = w >> 1, nb0 = (w & 1) * 2;
    LAS unsigned char* L = F.lds + RING_OFF;
#define SL(n) (L + (n) * MSZ)
    LAS float* TOT = (LAS float*)(F.lds + 131072 + 1024);
    LAS float* WE = TOT + 1024;
    bf16* yout = ptile(F, dir ? PT_RW_K : PT_RW_R);
    const int cp = F.tid & 31, sg = F.tid >> 5;
    float kac0, kac1; { const float* kap = W.rw_ka + opaque0() + h * 64 + 2 * cp; kac0 = kap[0]; kac1 = kap[1]; }
    const float z0 = __int_as_float(opaque0());
    f32x4 S[2]; S[0] = (f32x4){z0, z0, z0, z0}; S[1] = S[0];
#define RC_ROW(ci, s) (chunk_row0(b, scan_chunk(dir, (ci))) + (dir ? 63 - (s) : (s)))
    unsigned gr[4], gv[4], gk[4], gn[4], ga[4], ge[4];
    const unsigned char* const wsb = F.ws;
    const unsigned oR = (unsigned)(WS_Y + 0 * SZ_ROWS256), oV = (unsigned)(WS_Y + 1 * SZ_ROWS256), oK = (unsigned)(WS_Y + 2 * SZ_ROWS256), oN = (unsigned)(WS_Y + 3 * SZ_ROWS256);
    const unsigned oA = (unsigned)(WS_RW + (dir ? 1 : 0) * SZ_ROWS256), oE = (unsigned)(WS_RW + (dir ? 3 : 2) * SZ_ROWS256);
#define RC_LD(o_) (*(const unsigned*)(wsb + (size_t)((o_) + bo_)))
#define RC_LOAD(ci) do { _Pragma("unroll") for (int s4 = 0; s4 < 4; ++s4) { const unsigned bo_ = (unsigned)RC_ROW(ci, 4 * sg + s4) * 512u + (unsigned)((h * 64 + 2 * cp) * 2); \
        gr[s4] = RC_LD(oR); gv[s4] = RC_LD(oV); gk[s4] = RC_LD(oK); gn[s4] = RC_LD(oN); ga[s4] = RC_LD(oA); ge[s4] = RC_LD(oE); } } while (0)
    const int l15 = F.lane & 15, l4 = F.lane >> 4;
    const int jd = mb - nb0; const bool diag = (jd == 0 || jd == 1);
    unsigned mstrict = 0u, mincl = 0u;
#pragma unroll
    for (int r = 0; r < 4; ++r) { mstrict |= (4 * l4 + r < l15 ? 1u : 0u) << r; mincl |= (4 * l4 + r <= l15 ? 1u : 0u) << r; }
    const LAS unsigned char* pa_lo = L + (16 * mb + l15) * ROWB + 16 * l4; const LAS unsigned char* pa_hi = pa_lo + 7 * MSZ;
    const LAS unsigned char* pb_lo = L + (16 * nb0 + l15) * ROWB + 16 * l4; const LAS unsigned char* pb_hi = pb_lo + 7 * MSZ;
    LAS unsigned char* pr_lo = L + (16 * mb + 4 * l4) * ROWB + (16 * nb0 + l15) * 2; LAS unsigned char* pr_hi = pr_lo + 7 * MSZ;
    LAS unsigned char* pt_lo = L + (16 * nb0 + l15) * ROWB + (16 * mb + 4 * l4) * 2; LAS unsigned char* pt_hi = pt_lo + 7 * MSZ;
    asm volatile("" : "+v"(pa_hi), "+v"(pb_hi), "+v"(pr_hi), "+v"(pt_hi));
#define PA(n) ((n) < 7 ? pa_lo + (n) * MSZ : pa_hi + ((n) - 7) * MSZ)
#define PB(n) ((n) < 7 ? pb_lo + (n) * MSZ : pb_hi + ((n) - 7) * MSZ)
#define PR(n) ((n) < 7 ? pr_lo + (n) * MSZ : pr_hi + ((n) - 7) * MSZ)
#define PT(n) ((n) < 7 ? pt_lo + (n) * MSZ : pt_hi + ((n) - 7) * MSZ)
    RC_LOAD(0);
    v2u ypend[2];
#define RC_YSTORE(cprev) do { _Pragma("unroll") for (int j = 0; j < 2; ++j) { const int col_ = 16 * (nb0 + j) + (F.lane & 15); \
        *(v2u*)(yout + ((unsigned)RC_ROW(cprev, col_) * 256u + (unsigned)(h * 64 + 16 * mb + 4 * (F.lane >> 4)))) = ypend[j]; } } while (0)
    for (int ci = 0; ci < NCHUNK; ++ci) {
        {
            float e0[4], e1[4], cl0[4], cl1[4], c0 = 0.f, c1 = 0.f;
#pragma unroll
            for (int s4 = 0; s4 < 4; ++s4) { e0[s4] = bflo(ge[s4]); e1[s4] = bfhi(ge[s4]); c0 += e0[s4]; c1 += e1[s4]; cl0[s4] = c0; cl1[s4] = c1; }
            *(LAS f32x2_t*)(TOT + sg * 64 + 2 * cp) = (f32x2_t){c0, c1};
            __syncthreads();
            float off0 = 0.f, off1 = 0.f, tot0 = 0.f, tot1 = 0.f;
#pragma unroll
            for (int p = 0; p < 16; ++p) { const f32x2_t tp = *(const LAS f32x2_t*)(TOT + p * 64 + 2 * cp); tot0 += tp.x; tot1 += tp.y; off0 += (p < sg) ? tp.x : 0.f; off1 += (p < sg) ? tp.y : 0.f; }
            const float wend0 = fexp(-tot0), wend1 = fexp(-tot1);
            if (sg == 0) *(LAS f32x2_t*)(WE + 2 * cp) = (f32x2_t){wend0, wend1};
            float pprev0 = 0.f, pprev1 = 0.f;
            unsigned tA0[2], tA1[2], tV0[2], tV1[2], tB0[2], tB1[2], tK0[2], tK1[2];
#pragma unroll
            for (int s4 = 0; s4 < 4; ++s4) {
                const int s = 4 * sg + s4;
                const float cum0 = off0 + cl0[s4], cum1 = off1 + cl1[s4];
                const float p0 = fexp(-cum0), p1 = fexp(-cum1), pm0 = s4 == 0 ? fexp(-off0) : pprev0, pm1 = s4 == 0 ? fexp(-off1) : pprev1, q0 = frcp(p0), q1 = frcp(p1);
                pprev0 = p0; pprev1 = p1;
                const float n0 = bflo(gn[s4]), n1 = bfhi(gn[s4]), al0 = bflo(ga[s4]), al1 = bfhi(ga[s4]);
                const float bb0 = -n0 * al0, bb1 = -n1 * al1, kd0 = bflo(gk[s4]) * (1.0f + (al0 - 1.0f) * kac0), kd1 = bfhi(gk[s4]) * (1.0f + (al1 - 1.0f) * kac1);
                const unsigned wA = cvtpk(n0 * pm0, n1 * pm1), wR = cvtpk(bflo(gr[s4]) * p0, bfhi(gr[s4]) * p1), wB = cvtpk(bb0 * q0, bb1 * q1), wK = cvtpk(kd0 * q0, kd1 * q1);
                const unsigned wBe = cvtpk(bb0 * q0 * wend0, bb1 * q1 * wend1), wKe = cvtpk(kd0 * q0 * wend0, kd1 * q1 * wend1), wV = gv[s4];
                *(LAS unsigned*)(SL(0) + s * ROWB + 4 * cp) = wA; *(LAS unsigned*)(SL(1) + s * ROWB + 4 * cp) = wR; *(LAS unsigned*)(SL(2) + s * ROWB + 4 * cp) = wB; *(LAS unsigned*)(SL(3) + s * ROWB + 4 * cp) = wK;
                if (s4 & 1) { tA0[s4 >> 1] |= wA << 16; tA1[s4 >> 1] |= wA & 0xffff0000u; tV0[s4 >> 1] |= wV << 16; tV1[s4 >> 1] |= wV & 0xffff0000u;
                              tB0[s4 >> 1] |= wBe << 16; tB1[s4 >> 1] |= wBe & 0xffff0000u; tK0[s4 >> 1] |= wKe << 16; tK1[s4 >> 1] |= wKe & 0xffff0000u; }
                else { tA0[s4 >> 1] = wA & 0xffffu; tA1[s4 >> 1] = wA >> 16; tV0[s4 >> 1] = wV & 0xffffu; tV1[s4 >> 1] = wV >> 16;
                       tB0[s4 >> 1] = wBe & 0xffffu; tB1[s4 >> 1] = wBe >> 16; tK0[s4 >> 1] = wKe & 0xffffu; tK1[s4 >> 1] = wKe >> 16; }
            }
            const int r0 = (2 * cp) * ROWB + sg * 8, r1 = r0 + ROWB;
            *(LAS v2u*)(SL(4) + r0) = (v2u){tA0[0], tA0[1]}; *(LAS v2u*)(SL(4) + r1) = (v2u){tA1[0], tA1[1]}; *(LAS v2u*)(SL(5) + r0) = (v2u){tV0[0], tV0[1]}; *(LAS v2u*)(SL(5) + r1) = (v2u){tV1[0], tV1[1]};
            *(LAS v2u*)(SL(6) + r0) = (v2u){tB0[0], tB0[1]}; *(LAS v2u*)(SL(6) + r1) = (v2u){tB1[0], tB1[1]}; *(LAS v2u*)(SL(7) + r0) = (v2u){tK0[0], tK0[1]}; *(LAS v2u*)(SL(7) + r1) = (v2u){tK1[0], tK1[1]};
        }
        __syncthreads();
        if (ci > 0) RC_YSTORE(ci - 1);
        if (ci + 1 < NCHUNK) RC_LOAD(ci + 1);
        const f32x4 Z4 = (f32x4){z0, z0, z0, z0};
        f32x4 Tc[2], t0[2], t1[2], t2[2], t3[2];
        t0[0] = Z4; t0[1] = Z4; t1[0] = Z4; t1[1] = Z4; t2[0] = Z4; t2[1] = Z4; t3[0] = Z4; t3[1] = Z4;
#pragma unroll
        for (int j = 0; j < 2; ++j) if (nb0 + j >= mb) {
            mmb(t0[j], PA(2), PB(0) + j * 16 * ROWB); mmb(t1[j], PA(3), PB(0) + j * 16 * ROWB); mmb(t2[j], PA(2), PB(1) + j * 16 * ROWB); mmb(t3[j], PA(3), PB(1) + j * 16 * ROWB);
            if (nb0 + j == mb) {
#pragma unroll
                for (int r = 0; r < 4; ++r) { const bool st = (mstrict >> r) & 1, in = (mincl >> r) & 1; t0[j][r] = st ? t0[j][r] : 0.f; t1[j][r] = st ? t1[j][r] : 0.f; t2[j][r] = in ? t2[j][r] : 0.f; t3[j][r] = in ? t3[j][r] : 0.f; } } }
        f32x4 Mt = Z4;
        if (diag) mmb(Mt, PA(0), PA(2));
#pragma unroll
        for (int j = 0; j < 2; ++j) { stb_tr(PT(9) + j * 16 * ROWB, t0[j]); stb_tr(PT(10) + j * 16 * ROWB, t1[j]); stb_tr(PT(11) + j * 16 * ROWB, t2[j]); stb_tr(PT(12) + j * 16 * ROWB, t3[j]); }
        __syncthreads();
        f32x4 z2[2]; z2[0] = Z4; z2[1] = Z4;
        mmp(z2, PA(5), PB(10));
        Tc[0] = Z4; Tc[1] = Z4;
        if (diag) {
            const f32x4 M = jd == 0 ? t0[0] : t0[1];
            f32x4 T, Tt;
#pragma unroll
            for (int r = 0; r < 4; ++r) { const int ro = 4 * l4 + r;
                Mt[r] = ro > l15 ? Mt[r] : 0.f;
                T[r] = (ro == l15 ? 1.0f : 0.f) + ((ro + 1 == l15 && (ro & 1) == 0) ? M[r] : 0.f);
                Tt[r] = (ro == l15 ? 1.0f : 0.f) + ((l15 + 1 == ro && (l15 & 1) == 0) ? Mt[r] : 0.f); }
            const s16x4 oM = op16(M), oMt = op16(Mt);
#pragma unroll
            for (int n = 2; n <= 8; n *= 2) {
                const s16x4 oT = op16(T), oTt = op16(Tt);
                f32x4 Wm = mf16(oTt, oM, Z4);
                f32x4 Wt = mf16(oM, oTt, Z4);
#pragma unroll
                for (int r = 0; r < 4; ++r) { const int ro = 4 * l4 + r;
                    const bool okW = (ro / (2 * n) == l15 / (2 * n)) && (ro / n != l15 / n) && ro < l15;
                    const bool okT = (l15 / (2 * n) == ro / (2 * n)) && (l15 / n != ro / n) && l15 < ro;
                    Wm[r] = okW ? Wm[r] : 0.f; Wt[r] = okT ? Wt[r] : 0.f; }
                const s16x4 oW = op16(Wm), oWt = op16(Wt); (void)oW;
                T = mf16(oWt, oT, T);
                Tt = mf16(oT, oWt, Tt);
            }
            if (jd == 0) Tc[0] = T; else Tc[1] = T;
        }
#pragma unroll
        for (int j = 0; j < 2; ++j) { stb_row(PR(13) + j * 32, Tc[j]); stb_tr(PT(8) + j * 16 * ROWB, Tc[j]); }
        __syncthreads();
#define TLEVEL(COND, Trow, Ttr, TrowN, TtrN, EXTRA_B, LAST) do { \
        t0[0] = Z4; t0[1] = Z4; \
        _Pragma("unroll") for (int j = 0; j < 2; ++j) { const int nb = nb0 + j; if (COND) mmb(t0[j], PA(Trow), PB(9) + j * 16 * ROWB); stb_row(PR(0) + j * 32, t0[j]); } \
        __syncthreads(); \
        _Pragma("unroll") for (int j = 0; j < 2; ++j) { const int nb = nb0 + j; if (COND) mmb(Tc[j], PA(0), PB(Ttr) + j * 16 * ROWB); } \
        EXTRA_B; \
        _Pragma("unroll") for (int j = 0; j < 2; ++j) { if (!(LAST)) stb_row(PR(TrowN) + j * 32, Tc[j]); stb_tr(PT(TtrN) + j * 16 * ROWB, Tc[j]); } \
        __syncthreads(); } while (0)
        TLEVEL(((mb >> 1) == (nb >> 1) && mb < nb), 13, 8, 2, 3, { stb_row(PR(10), z2[0]); stb_row(PR(10) + 32, z2[1]); }, false);
        TLEVEL((mb < 2 && nb >= 2), 2, 3, 13, 8, (void)0, true);
#undef TLEVEL
        t0[0] = Z4; t0[1] = Z4; t1[0] = Z4; t1[1] = Z4;
        mmp(t0, PA(4), PB(8)); mmp(t1, PA(10), PB(8));
#pragma unroll
        for (int j = 0; j < 2; ++j) { stb_row(PR(0) + j * 32, t0[j]); stb_row(PR(3) + j * 32, t1[j]); }
        __syncthreads();
        f32x4 aS[2], aY[2]; aS[0] = Z4; aS[1] = Z4; aY[0] = Z4; aY[1] = Z4; t0[0] = Z4; t0[1] = Z4; t1[0] = Z4; t1[1] = Z4;
        mmp(t0, PA(0), PB(6)); mmp(t1, PA(0), PB(11));
#pragma unroll
        for (int j = 0; j < 2; ++j) { const v2u rw = *(const LAS v2u*)(PT(1) + j * 16 * ROWB);
            t1[j][0] += bflo(rw.x); t1[j][1] += bfhi(rw.x); t1[j][2] += bflo(rw.y); t1[j][3] += bfhi(rw.y); }
        mmp(aS, PA(3), PB(6)); mmp(aS, PA(5), PB(7)); mmp(aY, PA(3), PB(11)); mmp(aY, PA(5), PB(12));
#pragma unroll
        for (int j = 0; j < 2; ++j) { stb_tr(PT(9) + j * 16 * ROWB, t0[j]); stb_tr(PT(13) + j * 16 * ROWB, t1[j]); stb_row(PR(2) + j * 32, S[j]); }
        __syncthreads();
        mmp(aY, PA(2), PB(13)); mmp(aS, PA(2), PB(9));
#pragma unroll
        for (int j = 0; j < 2; ++j) { const float we = WE[16 * (nb0 + j) + l15];
            S[j] = S[j] * we + aS[j];
            ypend[j].x = cvtpk(aY[j][0], aY[j][1]); ypend[j].y = cvtpk(aY[j][2], aY[j][3]); }
        __syncthreads();
    }
    RC_YSTORE(NCHUNK - 1);
#undef RC_YSTORE
#undef PA
#undef PB
#undef PR
#undef PT
#undef SL
#undef RC_ROW
#undef RC_LOAD
#undef RC_LD
}
__device__ __forceinline__ void m2_queue(Frame& F, int l, int rep) {
    const LayerW W = layer_w(F, l);
    const bool need_ctx = l < NLAYER - 1;
    #ifndef RW_CHUNKED
#define RW_CHUNKED 1
#endif
    const int n0 = RW_CHUNKED ? 64 : 128, nA = n0 + 1024, nB = nA + (need_ctx ? 32 : 0), nC = nB + 64, nD = nC + 1024, nE = nD + (need_ctx ? 32 : 0);
    for (;;) {
        { int t_; asm volatile("v_mov_b32 %0, %1" : "=v"(t_) : "v"(threadIdx.x)); F.tid = t_; F.lane = t_ & 63; F.wave = __builtin_amdgcn_readfirstlane(t_ >> 6); }
        if (F.tid == 0) F.MISC[16] = __hip_atomic_fetch_add(F.ctl + CW_QUEUE + 64 * l + 128 * rep, 1u, RLX_AGENT);
        __syncthreads();
        const int it = (int)F.MISC[16];
        __syncthreads();
        if (it >= nE) break;
#ifdef MK_M2REP_KIND
        if (rep && (MK_M2REP_KIND == 1 ? it >= n0 : (it < n0 || (it >= nB && it < nC)))) continue;
#endif
        if (it < n0) { if (RW_CHUNKED) rwkv_chunk_item(F, W, it); else rwkv_scan_item(F, W, it); }
        else if (it < nA) attn_item(F, W, 0, it - n0, rep);
        else if (it < nB) attn_item(F, W, 1, it - nA, rep);
        else if (it < nC) { if (rep == 0) gla_b_item(F, it - nB); }
        else if (it < nD) attn_item(F, W, 2, it - nC, rep);
        else attn_item(F, W, 3, it - nD, rep);
    }
}

__device__ __forceinline__ void gla_c_issue(Frame& F, int item, v4u& w0, v4u& w1, v4u& wq, v4u& wk, v4u& wv, f32x4& s0, f32x4& s1, v2u& g0, v2u& g1) {
    const int bh = item / NCHUNK, c = item % NCHUNK, b = bh >> 2, h = bh & 3; const int rowc0 = chunk_row0(b, c);
    gla_low_issue(F, rowc0, w0, w1);
    const int i = (F.tid >> 2) & 63, cq = F.tid & 3;
    const bf16* qp = ptile(F, PT_GLA_QK) + (size_t)(rowc0 + i) * 256 + h * 32 + cq * 8; wq = *(const v4u*)qp; wk = *(const v4u*)(qp + 128);
    const int jv = F.tid >> 3, vq = F.tid & 7;
    wv = *(const v4u*)(ptile(F, PT_GLA_V) + (size_t)(rowc0 + jv) * 256 + h * 64 + vq * 8);
    const int e0 = F.tid * 8, dd = e0 >> 11, off = e0 & 2047;
    const float* gs = (const float*)(F.ws + WS_GLAS) + ((size_t)(bh * 2 + dd) * NCHUNK + c) * 2112 + off;
    s0 = *(const f32x4*)gs; s1 = *(const f32x4*)(gs + 4);
    const int l15 = F.lane & 15, l4 = F.lane >> 4, w = F.wave, ib = w & 3, vb0 = (w >> 2) * 2;
    const bf16* gp = ptile(F, PT_GLA_G) + ((size_t)rowc0 + 16 * ib + l15) * 256 + h * 64 + 16 * vb0 + 4 * l4;
    g0 = *(const v2u*)gp; g1 = *(const v2u*)(gp + 16);
}
__device__ __forceinline__ void gla_c_item(Frame& F, const LayerW& W, int item, int nxt, int nitems, v4u& w0, v4u& w1, v4u& wq_, v4u& wk_, v4u& wv_, f32x4& s0_, f32x4& s1_, v2u& g0_, v2u& g1_, f32x4 on0, f32x4 on1) {
    using namespace rwc;
    const int bh = item / NCHUNK, c = item % NCHUNK, b = bh >> 2, h = bh & 3; const int rowc0 = chunk_row0(b, c);
    LAS float* CUM = (LAS float*)(F.lds + RING_OFF);
    LAS unsigned char* SB = F.lds + RING_OFF + 16384;
    LAS float* SSQ = (LAS float*)(SB + 8 * MSZ);
#define GS(n) (SB + (n) * MSZ)
    {
        const int jv = F.tid >> 3, vq = F.tid & 7;
        const unsigned wvv[4] = {wv_.x, wv_.y, wv_.z, wv_.w};
#pragma unroll
        for (int e = 0; e < 8; ++e) *(LAS bf16*)(GS(5) + (vq * 8 + e) * ROWB + jv * 2) = (bf16)((e & 1) ? (wvv[e >> 1] >> 16) : (wvv[e >> 1] & 0xffffu));
        const int e0 = F.tid * 8, dd = e0 >> 11, off = e0 & 2047, cc2 = off >> 6, v0 = off & 63;
        const float sv[8] = {s0_.x, s0_.y, s0_.z, s0_.w, s1_.x, s1_.y, s1_.z, s1_.w};
#pragma unroll
        for (int e = 0; e < 8; ++e) *(LAS bf16*)(GS(6) + (v0 + e) * ROWB + (dd * 32 + cc2) * 2) = (bf16)(cvtpk(sv[e], sv[e]) & 0xffffu);
    }
    const v4u l0 = w0, l1 = w1, wq = wq_, wk = wk_; const v2u gg0 = g0_, gg1 = g1_;
    asm volatile("" ::: "memory");
    if (nxt < nitems) gla_c_issue(F, nxt, w0, w1, wq_, wk_, wv_, s0_, s1_, g0_, g1_);
    asm volatile("" ::: "memory");
    gla_decay_tables(F, W, h, l0, l1, CUM);
    {
        const int d = F.tid >> 8, i = (F.tid >> 2) & 63, cq = F.tid & 3;
        const float q[8] = {bflo(wq.x), bfhi(wq.x), bflo(wq.y), bfhi(wq.y), bflo(wq.z), bfhi(wq.z), bflo(wq.w), bfhi(wq.w)};
        const float k[8] = {bflo(wk.x), bfhi(wk.x), bflo(wk.y), bfhi(wk.y), bflo(wk.z), bfhi(wk.z), bflo(wk.w), bfhi(wk.w)};
        float qx[8], kx[8], qe[8];
#pragma unroll
        for (int e = 0; e < 8; ++e) { const int cc = cq * 8 + e; const float cm = CUM[(d * 64 + i) * 32 + cc], rf = d == 0 ? CUM[31 * 32 + cc] : CUM[(64 + 32) * 32 + cc];
            const float qs = q[e] * 0.17677669529663687f; qx[e] = qs * fexp(cm - rf); kx[e] = k[e] * fexp(rf - cm); qe[e] = qs * fexp(cm); }
        *(LAS v4u*)(GS(d) + i * ROWB + cq * 16) = (v4u){cvtpk(qx[0], qx[1]), cvtpk(qx[2], qx[3]), cvtpk(qx[4], qx[5]), cvtpk(qx[6], qx[7])};
        *(LAS v4u*)(GS(2 + d) + i * ROWB + cq * 16) = (v4u){cvtpk(kx[0], kx[1]), cvtpk(kx[2], kx[3]), cvtpk(kx[4], kx[5]), cvtpk(kx[6], kx[7])};
        *(LAS v4u*)(GS(4) + i * ROWB + d * 64 + cq * 16) = (v4u){cvtpk(qe[0], qe[1]), cvtpk(qe[2], qe[3]), cvtpk(qe[4], qe[5]), cvtpk(qe[6], qe[7])};
    }
    __syncthreads();
    const int l15 = F.lane & 15, l4 = F.lane >> 4, w = F.wave;
    {
        const int jb = w >> 1, ib0 = (w & 1) * 2;
#pragma unroll
        for (int jj = 0; jj < 2; ++jj) { const int ib = ib0 + jj; f32x4 acc = (f32x4){0.f, 0.f, 0.f, 0.f};
            if (jb <= ib) { f32x4 a = (f32x4){0.f, 0.f, 0.f, 0.f};
                a = __builtin_amdgcn_mfma_f32_16x16x32_bf16(*(const LAS bf16x8*)(GS(2) + (16 * jb + l15) * ROWB + 16 * l4), *(const LAS bf16x8*)(GS(0) + (16 * ib + l15) * ROWB + 16 * l4), a, 0, 0, 0);
                if (jb == ib) {
#pragma unroll
                    for (int r = 0; r < 4; ++r) a[r] = (4 * l4 + r <= l15) ? a[r] : 0.f; }
                acc += a; }
            if (jb >= ib) { f32x4 a = (f32x4){0.f, 0.f, 0.f, 0.f};
                a = __builtin_amdgcn_mfma_f32_16x16x32_bf16(*(const LAS bf16x8*)(GS(3) + (16 * jb + l15) * ROWB + 16 * l4), *(const LAS bf16x8*)(GS(1) + (16 * ib + l15) * ROWB + 16 * l4), a, 0, 0, 0);
                if (jb == ib) {
#pragma unroll
                    for (int r = 0; r < 4; ++r) a[r] = (4 * l4 + r >= l15) ? a[r] : 0.f; }
                acc += a; }
            stb_tr(GS(7) + (16 * ib + l15) * ROWB + (16 * jb + 4 * l4) * 2, acc); }
    }
    __syncthreads();
    {
        const int ib = w & 3, vb0 = (w >> 2) * 2;
        f32x4 o[2]; o[0] = (f32x4){0.f, 0.f, 0.f, 0.f}; o[1] = o[0];
#pragma unroll
        for (int vv = 0; vv < 2; ++vv) { const int vb = vb0 + vv;
            mmb(o[vv], GS(5) + (16 * vb + l15) * ROWB + 16 * l4, GS(7) + (16 * ib + l15) * ROWB + 16 * l4);
            mmb(o[vv], GS(6) + (16 * vb + l15) * ROWB + 16 * l4, GS(4) + (16 * ib + l15) * ROWB + 16 * l4); }
        float ss = 0.f;
#pragma unroll
        for (int vv = 0; vv < 2; ++vv)
#pragma unroll
            for (int r = 0; r < 4; ++r) ss += o[vv][r] * o[vv][r];
        ss += __shfl_xor(ss, 16); ss += __shfl_xor(ss, 32);
        if (l4 == 0) SSQ[w * 16 + l15] = ss;
        __syncthreads();
        const float rstd = 1.0f / sqrtf((SSQ[w * 16 + l15] + SSQ[(w ^ 4) * 16 + l15]) * (1.0f / 64.0f) + NORM_EPS);
        const size_t row = (size_t)rowc0 + 16 * ib + l15;
#pragma unroll
        for (int vv = 0; vv < 2; ++vv) { const int v0 = 16 * (vb0 + vv) + 4 * l4;
            const v2u wg = vv ? gg1 : gg0; const f32x4 on = vv ? on1 : on0;
            const float g[4] = {bflo(wg.x), bfhi(wg.x), bflo(wg.y), bfhi(wg.y)};
            float rr[4];
#pragma unroll
            for (int r = 0; r < 4; ++r) rr[r] = o[vv][r] * rstd * on[r] * (g[r] * fsigmoid(g[r]));
            v2u wo; wo.x = cvtpk(rr[0], rr[1]); wo.y = cvtpk(rr[2], rr[3]);
            *(v2u*)((bf16*)(F.ws + WS_HO) + row * 1024 + h * 64 + v0) = wo; }
    }
    __syncthreads();
#undef GS
}
__device__ __forceinline__ void rwkv_finish(Frame& F, const LayerW& W, int nrows) {
    const int gw = F.vcu * NWAVES + F.wave, NGW = F.G * NWAVES;
    const bf16 *yf = ptile(F, PT_RW_R), *yb = ptile(F, PT_RW_K);
    const bf16 *aR = rwarr(F, RA_R), *aV = rwarr(F, RA_V), *aK = rwarr(F, RA_K), *aAF = rwarr(F, RA_AF), *aAB = rwarr(F, RA_AB), *aG = rwarr(F, RA_G);
    bf16* O = (bf16*)(F.ws + WS_HO);
    const int sub = F.lane >> 5, c0 = (F.lane & 31) * 8;
    float lw[8], lb[8], ka[8], rk[8];
    { const int oz = opaque0(); const float *p0 = W.rw_lnw + c0 + oz, *p1 = W.rw_lnb + c0 + oz, *p2 = W.rw_ka + c0 + oz, *p3 = W.rw_rk + c0 + oz;
#pragma unroll
      for (int e = 0; e < 8; ++e) { lw[e] = p0[e]; lb[e] = p1[e]; ka[e] = p2[e]; rk[e] = p3[e]; } }
    const int npair = nrows >> 1;
#pragma unroll 4
    for (int it = gw; it < npair; it += NGW) {
        const size_t off = (size_t)(2 * it + sub) * 256 + c0;
        const v4u wyf = *(const v4u*)(yf + off), wyb = *(const v4u*)(yb + off), wr = *(const v4u*)(aR + off), wv = *(const v4u*)(aV + off), wk = *(const v4u*)(aK + off),
                  waf = *(const v4u*)(aAF + off), wab = *(const v4u*)(aAB + off), wg = *(const v4u*)(aG + off);
        const float y1[8] = UNPK(wyf), y2[8] = UNPK(wyb), r[8] = UNPK(wr), v[8] = UNPK(wv), k[8] = UNPK(wk), af[8] = UNPK(waf), ab[8] = UNPK(wab), g[8] = UNPK(wg);
        float y[8], s = 0.f, dot = 0.f;
#pragma unroll
        for (int e = 0; e < 8; ++e) { y[e] = y1[e] + y2[e]; s += y[e]; dot += r[e] * (k[e] * (2.0f + (af[e] + ab[e] - 2.0f) * ka[e])) * rk[e]; }
        const float mean = red8_dpp(s) * (1.0f / 64.0f); dot = red8_dpp(dot);
        float q = 0.f;
#pragma unroll
        for (int e = 0; e < 8; ++e) { y[e] -= mean; q += y[e] * y[e]; }
        const float rstd = __builtin_amdgcn_rsqf(red8_dpp(q) * (1.0f / 64.0f) + 64e-5f);
        float o[8];
#pragma unroll
        for (int e = 0; e < 8; ++e) o[e] = (y[e] * rstd * lw[e] + lb[e] + dot * v[e]) * g[e];
        v4u w; w.x = cvtpk(o[0], o[1]); w.y = cvtpk(o[2], o[3]); w.z = cvtpk(o[4], o[5]); w.w = cvtpk(o[6], o[7]);
        *(v4u*)(O + (size_t)(2 * it + sub) * 1024 + 768 + c0) = w;
    }
}
#ifndef M3_SWAP
#define M3_SWAP 0
#endif
__device__ __forceinline__ void m3_finish(Frame& F, int l) {
    const LayerW W = layer_w(F, l);
    const bool need_ctx = l < NLAYER - 1;
    gla_stage_wa(F, W);
    if (M3_SWAP && (F.vcu & 1)) rwkv_finish(F, W, need_ctx ? M_ALL : M_LAT);
    {
        const int N = 32 * NCHUNK;
        auto valid_from = [&](int it) { while (it < N && !need_ctx && (it % NCHUNK) < 4) it += F.G; return it; };
        const int l4 = F.lane >> 4, vb0 = (F.wave >> 2) * 2;
        const float* onp = W.gla_onorm + 16 * vb0 + 4 * l4 + opaque0(); const f32x4 on0 = *(const f32x4*)onp, on1 = *(const f32x4*)(onp + 16);
        int it = valid_from(F.vcu); v4u w0, w1, wq, wk, wv; f32x4 s0, s1; v2u g0, g1;
        if (it < N) gla_c_issue(F, it, w0, w1, wq, wk, wv, s0, s1, g0, g1);
        while (it < N) { const int nx = valid_from(it + F.G); gla_c_item(F, W, it, nx, N, w0, w1, wq, wk, wv, s0, s1, g0, g1, on0, on1); it = nx; }
    }
    if (!(M3_SWAP && (F.vcu & 1))) rwkv_finish(F, W, need_ctx ? M_ALL : M_LAT);
}
__device__ __forceinline__ void ctx_gemm_n1024(Frame& F, const bf16* A  , const bf16* Wt, bf16* Y  , int K) {
    using namespace rwc;
    LAS unsigned char* L = F.lds + RING_OFF;
    const int l15 = F.lane & 15, l4 = F.lane >> 4, w = F.wave, nbk = w >> 1, mb0 = (w & 1) * 2;
    const int srow = F.tid >> 3, sch = F.tid & 7;
    const int nk = K >> 8;
    for (int tile = F.vcu; tile < 32 * 16; tile += F.G) {
        const int tm = tile >> 4, tn = tile & 15;
        const bf16* ap = A + (size_t)(tm * 64 + srow) * K + sch * 8; const bf16* bp = Wt + (size_t)(tn * 64 + srow) * K + sch * 8;
        f32x4 acc[2]; acc[0] = (f32x4){0.f, 0.f, 0.f, 0.f}; acc[1] = acc[0];
        v4u r0[8], r1[8];
#define CG_LOAD(R, s_) do { _Pragma("unroll") for (int q = 0; q < 4; ++q) { R[q] = *(const v4u*)(ap + (s_) * 256 + q * 64); R[4 + q] = *(const v4u*)(bp + (s_) * 256 + q * 64); } } while (0)
#define CG_STORE(R) do { _Pragma("unroll") for (int q = 0; q < 8; ++q) *(LAS v4u*)(L + q * MSZ + srow * ROWB + sch * 16) = R[q]; } while (0)
        CG_LOAD(r0, 0); if (nk > 1) CG_LOAD(r1, 1);
        for (int s = 0; s < nk; ++s) {
            if ((s & 1) == 0) { CG_STORE(r0); if (s + 2 < nk) CG_LOAD(r0, s + 2); } else { CG_STORE(r1); if (s + 2 < nk) CG_LOAD(r1, s + 2); }
            __syncthreads();
#pragma unroll
            for (int q = 0; q < 4; ++q) mmp(acc, L + (4 + q) * MSZ + (16 * nbk + l15) * ROWB + 16 * l4, L + q * MSZ + (16 * mb0 + l15) * ROWB + 16 * l4);
            __syncthreads();
        }
#undef CG_LOAD
#undef CG_STORE
#pragma unroll
        for (int j = 0; j < 2; ++j) { v2u o; o.x = cvtpk(acc[j][0], acc[j][1]); o.y = cvtpk(acc[j][2], acc[j][3]);
            *(v2u*)(Y + (size_t)(tm * 64 + 16 * (mb0 + j) + l15) * 1024 + tn * 64 + 16 * nbk + 4 * l4) = o; }
    }
}
#ifndef MK_PER_PHASE
#define MK_PER_PHASE 0
#endif
#ifndef GEMM_REV
#define GEMM_REV 1
#endif
constexpr int NPH_LAYER = 12, NPHASES = 2 + NLAYER * NPH_LAYER;
#ifndef MK_PHASE_MASK
#define MK_PHASE_MASK 0x3fff
#endif
#define PH_EN(k) (((MK_PHASE_MASK) >> (k)) & 1)
#ifndef MK_REPEAT_MASK
#define MK_REPEAT_MASK 0
#endif
#ifndef MK_REP_L0ONLY
#define MK_REP_L0ONLY 0
#endif
#define NREP(k) (((((MK_REPEAT_MASK) >> (k)) & 1) && (!(MK_REP_L0ONLY) || l == 0)) ? 2 : 1)
struct Args { const float* in[28]; float* out; unsigned char* ws; int ph_lo, ph_hi; };
__global__ void __launch_bounds__(NTHREADS, 2) dit_fwd(Args args) {
    extern __shared__ __attribute__((aligned(16))) unsigned char lds[];
    Frame F;
    F.lds = (LAS unsigned char*)lds;
    F.MISC = (volatile LAS unsigned*)(F.lds + MISC_OFF);
    F.tid = threadIdx.x; F.lane = F.tid & 63; F.wave = __builtin_amdgcn_readfirstlane(F.tid >> 6);
    F.G = gridDim.x; { const int bx = blockIdx.x; F.vcu = (F.G % 8 == 0) ? (bx % 8) * (F.G / 8) + bx / 8 : bx; }
    F.ws = args.ws; F.out = args.out; F.ctl = (gu32*)(args.ws + WS_CTL);
#pragma unroll
    for (int i = 0; i < 28; ++i) F.in[i] = args.in[i];
    for (int u = F.tid; u < (LDS_BYTES - LDSCTL_OFF) / 4; u += NTHREADS) ((LAS unsigned*)(F.lds + LDSCTL_OFF))[u] = 0u;
    __syncthreads();
#if MK_PER_PHASE
#define GRID_BAR() do { } while (0)
#else
    XcdBarrier bar = xcd_barrier_post((unsigned*)(F.ctl + CW_BAR), F.MISC + 8);
#define GRID_BAR() xcd_barrier(bar)
#endif
    const int lo = args.ph_lo, hi = args.ph_hi;
#define IN(k) (lo <= (k) && (k) < hi)
#define SEAM(k) do { if (IN(k) && IN((k) + 1)) GRID_BAR(); } while (0)
#define RESEED() do { int t_; asm volatile("v_mov_b32 %0, %1" : "=v"(t_) : "v"(threadIdx.x)); F.tid = t_; F.lane = t_ & 63; F.wave = __builtin_amdgcn_readfirstlane(t_ >> 6); \
        int b_; asm volatile("s_mov_b32 %0, %1" : "=s"(b_) : "s"(blockIdx.x)); F.vcu = (F.G % 8 == 0) ? (b_ % 8) * (F.G / 8) + b_ / 8 : b_; F.bid = b_; } while (0)
    bf16* const H = (bf16*)(F.ws + WS_HO); bf16* const Y = (bf16*)(F.ws + WS_Y); bf16* const U = (bf16*)(F.ws + WS_UP);
    bf16* const XB = (bf16*)F.out; bf16* const XB2 = (bf16*)(F.ws + WS_KC);
    float* const XC = (float*)(F.ws + WS_XC); const float* const MODV = (const float*)(F.ws + WS_MODV);
    LAS unsigned char* const ring = F.lds + RING_OFF;

    if (PH_EN(12) && IN(0)) { RESEED(); p0_prologue<1>(F); } SEAM(0);
    if (IN(1)) for (int rep = 0, l = 0; rep < NREP(12); ++rep) { if (rep) GRID_BAR();
        if (F.vcu & 1) { if (PH_EN(12)) { RESEED(); p0_prologue<2>(F); } }
        if (PH_EN(13)) { RESEED();
            thin_phase<false, true>(F, nullptr, F.in[I_X], F.in[I_CTX], nullptr, nullptr, nullptr, nullptr, 0.f, F.in[I_NORMG], MODV + 0 * 1024, MODV + 1 * 1024, H, M_ALL); }
        if (!(F.vcu & 1)) { if (PH_EN(12)) { RESEED(); p0_prologue<2>(F); } }
    } SEAM(1);
    for (int l = 0; l < NLAYER; ++l) {
        const int pb = 2 + l * NPH_LAYER;
        const bool need_ctx = l < NLAYER - 1;
        const float* ng = F.in[I_NORMG] + (size_t)l * 6 * DM; const float* mv = MODV + (size_t)l * 9 * 9216;
        const int m_post = need_ctx ? M_ALL : M_LAT;
        const bf16* W13 = (const bf16*)(F.ws + WS_W13) + (size_t)l * 2 * (2 * DFF) * DM; const bf16* W2 = (const bf16*)(F.ws + WS_W2) + (size_t)l * 2 * DM * DFF;
        const bf16* WIN = (const bf16*)(F.ws + WS_WIN) + (size_t)l * PW * DM; const bf16* WOUT = (const bf16*)(F.ws + WS_WOUT) + (size_t)l * DM * DM;
        if (PH_EN(0) && IN(pb + 0)) for (int rep = 0; rep < NREP(0); ++rep) { if (rep) GRID_BAR(); RESEED();
            pg8::Gemm g{H, W13, M_ALL, 2 * DFF, DM}; pg8::StaticOrder S; S.init(M_ALL, 2 * DFF, F.G, F.bid);
            pg8::EpiSwiglu E{U, DFF};
            pg8::gemm_phase<pg8::EpiSwiglu, pg8::StaticOrder, true, true>(ring, g, S, E);
        } SEAM(pb + 0);
        if (PH_EN(1) && IN(pb + 1)) for (int rep = 0; rep < NREP(1); ++rep) { if (rep) GRID_BAR(); RESEED();
            pg8::Gemm g{U, W2, M_LAT, DM, DFF}; pg8::StaticOrder S; S.init(M_LAT, DM, F.G, F.bid, GEMM_REV);
            pg8::EpiBf16<0> E{Y, DM, nullptr, 0, 0, 1.f};
            pg8::gemm_phase<pg8::EpiBf16<0>, pg8::StaticOrder, true, true>(ring, g, S, E);
            ctx_gemm_n1024(F, U + (size_t)M_LAT * DFF, W2, Y + (size_t)M_LAT * DM, DFF);
        } SEAM(pb + 1);
        if (PH_EN(2) && IN(pb + 2)) for (int rep = 0; rep < NREP(2); ++rep) { if (rep) GRID_BAR(); RESEED();
            if (l == 0) thin_phase<true, true, false, true>(F, Y, F.in[I_X], F.in[I_CTX], XB, XC, ng + 1 * DM, mv + 2 * 1024, 0.5f, ng + 2 * DM, mv + 3 * 1024, mv + 4 * 1024, H, M_ALL);
            else thin_phase<true, true, true, true>(F, Y, XB, XC, XB, XC, ng + 1 * DM, mv + 2 * 1024, 0.5f, ng + 2 * DM, mv + 3 * 1024, mv + 4 * 1024, H, M_ALL);
        } SEAM(pb + 2);
        if (PH_EN(3) && IN(pb + 3)) for (int rep = 0; rep < NREP(3); ++rep) { if (rep) GRID_BAR(); RESEED();
            pg8::Gemm g{H, WIN, M_ALL, PW, DM}; pg8::StaticOrder S; S.init(M_ALL, PW, F.G, F.bid);
            pg8::EpiBf16<0> E{U, 256, nullptr, 256, (size_t)M_ALL * 256, 1.f};
            pg8::gemm_phase<pg8::EpiBf16<0>, pg8::StaticOrder, true, true>(ring, g, S, E);
        } SEAM(pb + 3);
        if (PH_EN(4) && IN(pb + 4)) for (int rep = 0; rep < NREP(4); ++rep) { if (rep) GRID_BAR(); RESEED(); m1_prep(F, l, rep); } SEAM(pb + 4);
        if (PH_EN(5) && IN(pb + 5)) for (int rep = 0; rep < NREP(5); ++rep) { if (rep) GRID_BAR(); RESEED(); m2_queue(F, l, rep); } SEAM(pb + 5);
        if (PH_EN(6) && IN(pb + 6)) for (int rep = 0; rep < NREP(6); ++rep) { if (rep) GRID_BAR(); RESEED(); m3_finish(F, l); } SEAM(pb + 6);
        if (PH_EN(7) && IN(pb + 7)) for (int rep = 0; rep < NREP(7); ++rep) { if (rep) GRID_BAR(); RESEED();
            pg8::Gemm g{H, WOUT, M_LAT, DM, DM}; pg8::StaticOrder S; S.init(M_LAT, DM, F.G, F.bid);
            pg8::EpiBf16<0> E{Y, DM, nullptr, 0, 0, 1.f};
            pg8::gemm_phase<pg8::EpiBf16<0>, pg8::StaticOrder, true, true>(ring, g, S, E);
            if (need_ctx) ctx_gemm_n1024(F, H + (size_t)M_LAT * DM, WOUT, Y + (size_t)M_LAT * DM, DM);
        } SEAM(pb + 7);
        if (PH_EN(8) && IN(pb + 8)) for (int rep = 0; rep < NREP(8); ++rep) { if (rep) GRID_BAR(); RESEED();
            thin_phase<true, true, true, true>(F, Y, XB, XC, need_ctx ? XB : XB2, XC, ng + 3 * DM, mv + 5 * 1024, 1.0f, ng + 4 * DM, mv + 6 * 1024, mv + 7 * 1024, H, m_post);
        } SEAM(pb + 8);
        if (PH_EN(9) && IN(pb + 9)) for (int rep = 0; rep < NREP(9); ++rep) { if (rep) GRID_BAR(); RESEED();
            pg8::Gemm g{H, W13 + (size_t)(2 * DFF) * DM, m_post, 2 * DFF, DM}; pg8::StaticOrder S; S.init(m_post, 2 * DFF, F.G, F.bid);
            pg8::EpiSwiglu E{U, DFF};
            pg8::gemm_phase<pg8::EpiSwiglu, pg8::StaticOrder, true, true>(ring, g, S, E);
        } SEAM(pb + 9);
        if (PH_EN(10) && IN(pb + 10)) for (int rep = 0; rep < NREP(10); ++rep) { if (rep) GRID_BAR(); RESEED();
            pg8::Gemm g{U, W2 + (size_t)DM * DFF, M_LAT, DM, DFF}; pg8::StaticOrder S; S.init(M_LAT, DM, F.G, F.bid, GEMM_REV);
            pg8::EpiBf16<0> E{Y, DM, nullptr, 0, 0, 1.f};
            pg8::gemm_phase<pg8::EpiBf16<0>, pg8::StaticOrder, true, true>(ring, g, S, E);
            if (need_ctx) ctx_gemm_n1024(F, U + (size_t)M_LAT * DFF, W2 + (size_t)DM * DFF, Y + (size_t)M_LAT * DM, DFF);
        } SEAM(pb + 10);
        if (PH_EN(11) && IN(pb + 11)) for (int rep = 0; rep < NREP(11); ++rep) { if (rep) GRID_BAR(); RESEED();
            if (need_ctx) thin_phase<true, true, true, true>(F, Y, XB, XC, XB, XC, ng + 5 * DM, mv + 8 * 1024, 0.5f, ng + 6 * DM, mv + 9 * 9216 + 0 * 1024, mv + 9 * 9216 + 1 * 1024, H, m_post);
            else thin_phase<true, false, true, false>(F, Y, XB2, XC, F.out, XC, ng + 5 * DM, mv + 8 * 1024, 0.5f, nullptr, nullptr, nullptr, nullptr, m_post);
        } SEAM(pb + 11);
    }
#undef IN
#undef SEAM
}

extern "C" void kernel_launch(void* const* d_in, const int* in_sizes, int n_in, void* d_out, int out_size, void* d_ws, size_t ws_size, hipStream_t stream) {
    static int grid = 0;
    if (grid == 0) {
        if (n_in != 28 || in_sizes[0] != M_LAT * DM || out_size != M_LAT * DM || ws_size < WS_END) {
            fprintf(stderr, "kernel_launch: unexpected shapes: n_in %d in0 %d out %d ws %zu (need >= %zu); nothing launched\n", n_in, n_in > 0 ? in_sizes[0] : -1, out_size, ws_size, (size_t)WS_END); grid = -1; return; }
        int dev = 0, cus = 0, per_cu = 0;
        if (hipGetDevice(&dev) != hipSuccess || hipDeviceGetAttribute(&cus, hipDeviceAttributeMultiprocessorCount, dev) != hipSuccess) { fprintf(stderr, "kernel_launch: device query failed\n"); grid = -1; return; }
        if (hipFuncSetAttribute((const void*)dit_fwd, hipFuncAttributeMaxDynamicSharedMemorySize, LDS_BYTES) != hipSuccess) { fprintf(stderr, "kernel_launch: hipFuncSetAttribute failed\n"); grid = -1; return; }
        if (hipOccupancyMaxActiveBlocksPerMultiprocessor(&per_cu, (const void*)dit_fwd, NTHREADS, LDS_BYTES) != hipSuccess || per_cu < 1)
            fprintf(stderr, "kernel_launch: note: occupancy query reports %d workgroups per CU\n", per_cu);
        (void)hipGetLastError();
        grid = cus;
    }
    if (grid < 0) return;
    if (hipMemsetAsync((char*)d_ws + WS_CTL, 0, CTL_ZERO_BYTES, stream) != hipSuccess) { fprintf(stderr, "kernel_launch: memset failed\n"); return; }
    Args a{};
    for (int i = 0; i < 28; ++i) a.in[i] = (const float*)d_in[i];
    a.out = (float*)d_out; a.ws = (unsigned char*)d_ws;
#if MK_PER_PHASE
    for (int p = 0; p < NPHASES; ++p) { a.ph_lo = p; a.ph_hi = p + 1; hipLaunchKernelGGL(dit_fwd, dim3(grid), dim3(NTHREADS), LDS_BYTES, stream, a); }
#else
    a.ph_lo = 0; a.ph_hi = NPHASES;
    hipLaunchKernelGGL(dit_fwd, dim3(grid), dim3(NTHREADS), LDS_BYTES, stream, a);
#endif
    const hipError_t le = hipPeekAtLastError();
    if (le != hipSuccess) fprintf(stderr, "kernel_launch: launch failed: %s\n", hipGetErrorName(le));
}
```

```cpp
#include <hip/hip_runtime.h>
#include <cstdio>
#include <cstdint>
#include <cmath>
namespace pg8 {
#define PG8_LAS __attribute__((address_space(3)))
typedef unsigned short bf16_t;
typedef short bf16x8 __attribute__((ext_vector_type(8)));
typedef float f32x4 __attribute__((ext_vector_type(4)));
typedef unsigned u32x4 __attribute__((ext_vector_type(4)));
constexpr int BM = 256, BK = 64, HALF = 128, HTB = HALF * BK * 2  , STAGE_BYTES = 8 * HTB, NXCD = 8, WGM = 8;

__host__ __device__ __forceinline__ int lds_byte(int r, int c) { const int st = (r >> 4) * 2 + (c >> 5), rr = r & 15, cc = c & 31, ob = rr * 64 + cc * 2; return st * 1024 + (ob ^ (((ob >> 9) & 1) << 5)); }
__host__ __device__ __forceinline__ void stage_rc(int b, int& R, int& C) { const int st = b / 1024, sb = b % 1024, swz = sb ^ (((sb >> 9) & 1) << 5); R = (st >> 1) * 16 + swz / 64; C = (st & 1) * 32 + (swz % 64) / 2; }
__host__ __device__ __forceinline__ int perm32(int rho) { const int n = rho >> 4, i = rho & 15; return 8 * (i >> 2) + 4 * n + (i & 3); }

struct Unit { int pm, pn; };
struct Gemm { const bf16_t* A; const bf16_t* Bt; int M, N, K; };

struct StaticOrder {
    int nM, nN, nwg, G, c, rev;
    __host__ __device__ void init(int M, int N, int G_, int c_, int rev_ = 0) { nM = M / BM; nN = N / BM; nwg = nM * nN; G = G_; c = c_; rev = rev_; }
    __host__ __device__ bool next(int i, Unit& u) const {
        const long L = (long)i * G + c; if (L >= nwg) return false;
        int wgid = (int)L; { const int q = nwg / NXCD, r = nwg % NXCD, xcd = wgid % NXCD, off = wgid / NXCD; wgid = (xcd < r ? xcd * (q + 1) : r * (q + 1) + (xcd - r) * q) + off; }
        const int nig = WGM * nN, gid = wgid / nig, fm = gid * WGM, gsz = (nM - fm) < WGM ? (nM - fm) : WGM;
        u.pm = fm + ((wgid % nig) % gsz); u.pn = (wgid % nig) / gsz; if (rev) { u.pm = nM - 1 - u.pm; u.pn = nN - 1 - u.pn; } return true;
    }
    __device__ __forceinline__ void a_ready(const Unit&) const {}
    __device__ __forceinline__ void done(const Unit&) const {}
};

__device__ __forceinline__ unsigned cvt_pk_bf16(float lo, float hi) { unsigned r; asm volatile("v_cvt_pk_bf16_f32 %0, %1, %2" : "=v"(r) : "v"(lo), "v"(hi)); return r; }
typedef float f32x2 __attribute__((ext_vector_type(2)));
__device__ __forceinline__ f32x2 gelu_pk(f32x2 v) {
    const f32x2 av = __builtin_elementwise_abs(v), d = av * 0.2316418882f + 1.0f;
    f32x2 t; t.x = __builtin_amdgcn_rcpf(d.x); t.y = __builtin_amdgcn_rcpf(d.y);
    f32x2 q = t * 0.5307027145f + (-0.7265760135f); q = q * t + 0.7107068705f; q = q * t + (-0.142248368f); q = q * t + 0.127414796f; q = q * t;
    const f32x2 s = (v * v) * (-0.72134752044f);
    f32x2 e; e.x = __builtin_amdgcn_exp2f(s.x); e.y = __builtin_amdgcn_exp2f(s.y);
    const f32x2 m = v * (q * e), r = v - m;
    f32x2 o; o.x = v.x < 0.f ? m.x : r.x; o.y = v.y < 0.f ? m.y : r.y; return o;
}

template <int ACT  > struct EpiBf16 {
    static constexpr bool PERM = true, AFTER_DRAIN = false; static_assert(ACT == 0 || ACT == 1, "EpiBf16: ACT is 0 (none) or 1 (gelu_pk)");
    bf16_t* O; int ldc; const float* bias; int split_cols; size_t split_stride; float scale0;
    __device__ __forceinline__ void operator()(const f32x4 (&acc)[2][2][4][2], const Unit& u, int wr, int wc, int fr, int fq) const {
        const int row0 = u.pm * BM + wr * 64 + fr; int colt = u.pn * BM; bf16_t* base = O;
        float sc = 1.f; if (split_cols) { const int t = colt / split_cols; base += (size_t)t * split_stride; colt -= t * split_cols; if (t == 0) sc = scale0; }
        const int col0 = colt + wc * 32 + 8 * fq, bcol0 = u.pn * BM + wc * 32 + 8 * fq;
        f32x4 bv[2][2];
#pragma unroll
        for (int bj = 0; bj < 2; ++bj)
#pragma unroll
            for (int n = 0; n < 2; ++n) bv[bj][n] = bias ? *(const f32x4*)(bias + bcol0 + bj * HALF + 4 * n) : (f32x4){0.f, 0.f, 0.f, 0.f};
#pragma unroll
        for (int ai = 0; ai < 2; ++ai)
#pragma unroll
            for (int m = 0; m < 4; ++m) { bf16_t* rowp = base + (size_t)(row0 + ai * HALF + m * 16) * ldc + col0;
#pragma unroll
                for (int bj = 0; bj < 2; ++bj) { f32x4 v0 = acc[ai][bj][m][0] + bv[bj][0], v1 = acc[ai][bj][m][1] + bv[bj][1];
                    if (ACT == 1) { f32x2 a = gelu_pk((f32x2){v0[0], v0[1]}), b = gelu_pk((f32x2){v0[2], v0[3]}), c = gelu_pk((f32x2){v1[0], v1[1]}), d = gelu_pk((f32x2){v1[2], v1[3]});
                        v0 = (f32x4){a.x, a.y, b.x, b.y}; v1 = (f32x4){c.x, c.y, d.x, d.y}; }
                    v0 = v0 * sc; v1 = v1 * sc; u32x4 w; w.x = cvt_pk_bf16(v0[0], v0[1]); w.y = cvt_pk_bf16(v0[2], v0[3]); w.z = cvt_pk_bf16(v1[0], v1[1]); w.w = cvt_pk_bf16(v1[2], v1[3]);
                    *(u32x4*)(rowp + bj * HALF) = w; } }
    }
};

struct EpiSwiglu {
    static constexpr bool PERM = true, AFTER_DRAIN = false;
    bf16_t* O; int ldc;
    __device__ __forceinline__ void operator()(const f32x4 (&acc)[2][2][4][2], const Unit& u, int wr, int wc, int fr, int fq) const {
        const int row0 = u.pm * BM + wr * 64 + fr; const int col0 = u.pn * HALF + wc * 32 + 8 * fq;
#pragma unroll
        for (int ai = 0; ai < 2; ++ai)
#pragma unroll
            for (int m = 0; m < 4; ++m) { bf16_t* rowp = O + (size_t)(row0 + ai * HALF + m * 16) * ldc + col0;
                float r[8];
#pragma unroll
                for (int n = 0; n < 2; ++n)
#pragma unroll
                    for (int e = 0; e < 4; ++e) { const float a = acc[ai][0][m][n][e], b = acc[ai][1][m][n][e];
                        const float sg = __builtin_amdgcn_rcpf(1.0f + __builtin_amdgcn_exp2f(-1.4426950408889634f * a)); r[n * 4 + e] = a * sg * b; }
                u32x4 w; w.x = cvt_pk_bf16(r[0], r[1]); w.y = cvt_pk_bf16(r[2], r[3]); w.z = cvt_pk_bf16(r[4], r[5]); w.w = cvt_pk_bf16(r[6], r[7]);
                *(u32x4*)rowp = w; }
    }
};
template <class Epi, class Sched, bool ALIGN_EPI = false, bool SP2 = false>
__device__ __forceinline__ void gemm_phase(PG8_LAS unsigned char* lds, const Gemm g, const Sched& S, const Epi& E) {
    int tid_; asm volatile("v_mov_b32 %0, %1" : "=v"(tid_) : "v"(threadIdx.x));
    const int tid = tid_, wid = __builtin_amdgcn_readfirstlane(tid >> 6), lane = tid & 63, wr = wid >> 2, wc = wid & 3, fr = lane & 15, fq = lane >> 4;
    const int K = g.K, nt = K / BK;
    unsigned voffA[2], voffB[2];
#pragma unroll
    for (int i = 0; i < 2; ++i) { int R, C; stage_rc(tid * 16 + i * 8192, R, C); const int Rb = Epi::PERM ? ((R & ~31) + perm32(R & 31)) : R;
        voffA[i] = (unsigned)(R * K + C) * 2u; voffB[i] = (unsigned)(Rb * K + C) * 2u; }
    const size_t kstep = (size_t)(BK * 2);
    const size_t hstep = (size_t)HALF * K * 2;
    const size_t tstep = 2 * hstep;
    const unsigned ldsw = (unsigned)wid * 1024u;
    const int aoff = lds_byte(wr * 64 + fr, fq * 8), boff = lds_byte(wc * 32 + fr, fq * 8);
#define PG8_SA(b, h) (((b) * 2 + (h)) * HTB)
#define PG8_SB(b, h) ((4 + (b) * 2 + (h)) * HTB)
#define PG8_STAGE(bufoff, gbase, voff) do { _Pragma("unroll") for (int _i = 0; _i < 2; ++_i) \
        __builtin_amdgcn_global_load_lds((const unsigned*)((const char*)(gbase) + (voff)[_i]), (PG8_LAS unsigned*)(lds + (bufoff) + ldsw + _i * 8192), 16, 0, 0); } while (0)
#define PG8_LDA(dst, b, h) do { _Pragma("unroll") for (int m = 0; m < 4; ++m) _Pragma("unroll") for (int k = 0; k < 2; ++k) dst[m][k] = *(const PG8_LAS bf16x8*)(lds + PG8_SA(b, h) + aoff + m * 2048 + k * 1024); } while (0)
#define PG8_LDB(dst, b, h) do { _Pragma("unroll") for (int n = 0; n < 2; ++n) _Pragma("unroll") for (int k = 0; k < 2; ++k) dst[n][k] = *(const PG8_LAS bf16x8*)(lds + PG8_SB(b, h) + boff + n * 2048 + k * 1024); } while (0)
#define PG8_MMA(ai, bj, At, Bt) do { __builtin_amdgcn_s_setprio(1); _Pragma("unroll") for (int m = 0; m < 4; ++m) _Pragma("unroll") for (int n = 0; n < 2; ++n) _Pragma("unroll") for (int k = 0; k < 2; ++k) \
        acc[ai][bj][m][n] = __builtin_amdgcn_mfma_f32_16x16x32_bf16(Bt[n][k], At[m][k], acc[ai][bj][m][n], 0, 0, 0); __builtin_amdgcn_s_setprio(0); } while (0)
#define PG8_WAIT_V(n) asm volatile("s_waitcnt vmcnt(" #n ")" ::: "memory")
#define PG8_WAIT_L(n) asm volatile("s_waitcnt lgkmcnt(" #n ")" ::: "memory")
#define PG8_BAR __builtin_amdgcn_s_barrier()
#define PG8_SCHED __builtin_amdgcn_sched_barrier(0)
    Unit cur, nxt; int ui = 0;
    if (!S.next(0, cur)) return;
    f32x4 acc[2][2][4][2];
#pragma unroll
    for (int a = 0; a < 2; ++a)
#pragma unroll
        for (int b = 0; b < 2; ++b)
#pragma unroll
            for (int m = 0; m < 4; ++m)
#pragma unroll
                for (int n = 0; n < 2; ++n) acc[a][b][m][n] = (f32x4){0.f, 0.f, 0.f, 0.f};
    bf16x8 At[4][2], B0[2][2], B1[2][2];
    const char* cA = (const char*)g.A + (size_t)cur.pm * tstep; const char* cB = (const char*)g.Bt + (size_t)cur.pn * tstep;
    S.a_ready(cur);
    if constexpr (SP2) {
        PG8_STAGE(PG8_SB(0, 0), cB, voffB); PG8_STAGE(PG8_SB(0, 1), cB + hstep, voffB); PG8_STAGE(PG8_SA(0, 0), cA, voffA); PG8_STAGE(PG8_SA(0, 1), cA + hstep, voffA);
        if (wr == 1) PG8_BAR;
        PG8_WAIT_V(2); PG8_BAR;
        PG8_STAGE(PG8_SB(1, 0), cB + kstep, voffB); PG8_STAGE(PG8_SA(1, 0), cA + kstep, voffA); PG8_STAGE(PG8_SB(1, 1), cB + hstep + kstep, voffB);
        PG8_WAIT_V(6); PG8_BAR;
    } else {
        PG8_STAGE(PG8_SB(0, 0), cB, voffB); PG8_STAGE(PG8_SA(0, 0), cA, voffA); PG8_STAGE(PG8_SB(0, 1), cB + hstep, voffB); PG8_STAGE(PG8_SA(0, 1), cA + hstep, voffA);
        if (wr == 1) PG8_BAR;
        PG8_WAIT_V(4); PG8_BAR;
        PG8_STAGE(PG8_SB(1, 0), cB + kstep, voffB); PG8_STAGE(PG8_SA(1, 0), cA + kstep, voffA); PG8_STAGE(PG8_SB(1, 1), cB + hstep + kstep, voffB);
        PG8_WAIT_V(6); PG8_BAR;
    }
    for (;;) {
        const bool has_next = S.next(ui + 1, nxt);
        const char* nA = has_next ? (const char*)g.A + (size_t)nxt.pm * tstep : cA; const char* nB = has_next ? (const char*)g.Bt + (size_t)nxt.pn * tstep : cB;
        for (int t = 0; t < nt; t += 2) {
            const bool last = (t == nt - 2);
            const char* a1 = cA + (size_t)(t + 1) * kstep;
            const char* a2 = last ? nA : cA + (size_t)(t + 2) * kstep; const char* b2 = last ? nB : cB + (size_t)(t + 2) * kstep;
            const char* a3 = a2 + kstep; const char* b3 = b2 + kstep;
            if (last && has_next) S.a_ready(nxt);
            if constexpr (SP2) {
            PG8_LDB(B0, 0, 0); PG8_LDB(B1, 0, 1); PG8_SCHED; PG8_LDA(At, 0, 0); PG8_STAGE(PG8_SA(1, 1), a1 + hstep, voffA);
            PG8_WAIT_V(8); PG8_WAIT_L(0); PG8_BAR; PG8_MMA(0, 0, At, B0); PG8_MMA(0, 1, At, B1); PG8_BAR; PG8_SCHED;
            PG8_LDA(At, 0, 1); PG8_STAGE(PG8_SB(0, 0), b2, voffB); PG8_STAGE(PG8_SB(0, 1), b2 + hstep, voffB); PG8_STAGE(PG8_SA(0, 0), a2, voffA);
            PG8_WAIT_V(8); PG8_WAIT_L(0); PG8_BAR; PG8_MMA(1, 0, At, B0); PG8_MMA(1, 1, At, B1); PG8_BAR; PG8_SCHED;
            PG8_LDB(B0, 1, 0); PG8_LDB(B1, 1, 1); PG8_SCHED; PG8_LDA(At, 1, 0); PG8_STAGE(PG8_SA(0, 1), a2 + hstep, voffA);
            PG8_WAIT_V(8); PG8_WAIT_L(0); PG8_BAR; PG8_MMA(0, 0, At, B0); PG8_MMA(0, 1, At, B1); PG8_BAR; PG8_SCHED;
            PG8_LDA(At, 1, 1); PG8_STAGE(PG8_SB(1, 0), b3, voffB); PG8_STAGE(PG8_SB(1, 1), b3 + hstep, voffB); PG8_STAGE(PG8_SA(1, 0), a3, voffA);
            PG8_WAIT_V(8); PG8_WAIT_L(0); PG8_BAR; PG8_MMA(1, 0, At, B0); PG8_MMA(1, 1, At, B1); PG8_BAR; PG8_SCHED;
            } else {
            PG8_LDB(B0, 0, 0); PG8_SCHED; PG8_LDA(At, 0, 0); PG8_STAGE(PG8_SA(1, 1), a1 + hstep, voffA);
            PG8_WAIT_L(8); PG8_BAR; PG8_WAIT_L(0); PG8_MMA(0, 0, At, B0); PG8_BAR; PG8_SCHED;
            PG8_LDB(B1, 0, 1); PG8_STAGE(PG8_SB(0, 0), b2, voffB);
            PG8_BAR; PG8_WAIT_L(0); PG8_MMA(0, 1, At, B1); PG8_BAR;
            PG8_LDA(At, 0, 1); PG8_STAGE(PG8_SA(0, 0), a2, voffA);
            PG8_BAR; PG8_WAIT_L(0); PG8_MMA(1, 0, At, B0); PG8_BAR; PG8_SCHED;
            PG8_STAGE(PG8_SB(0, 1), b2 + hstep, voffB);
            PG8_WAIT_V(6); PG8_BAR; PG8_MMA(1, 1, At, B1); PG8_BAR;
            PG8_LDB(B0, 1, 0); PG8_SCHED; PG8_LDA(At, 1, 0); PG8_STAGE(PG8_SA(0, 1), a2 + hstep, voffA);
            PG8_WAIT_L(8); PG8_BAR; PG8_WAIT_L(0); PG8_MMA(0, 0, At, B0); PG8_BAR; PG8_SCHED;
            PG8_LDB(B1, 1, 1); PG8_STAGE(PG8_SB(1, 0), b3, voffB);
            PG8_BAR; PG8_WAIT_L(0); PG8_MMA(0, 1, At, B1); PG8_BAR;
            PG8_LDA(At, 1, 1); PG8_STAGE(PG8_SA(1, 0), a3, voffA);
            PG8_BAR; PG8_WAIT_L(0); PG8_MMA(1, 0, At, B0); PG8_BAR; PG8_SCHED;
            PG8_STAGE(PG8_SB(1, 1), b3 + hstep, voffB);
            PG8_WAIT_V(6); PG8_BAR; PG8_MMA(1, 1, At, B1); PG8_BAR;
            }
        }
        if constexpr (ALIGN_EPI) { if (wr == 0) PG8_BAR; }
        if constexpr (!Epi::AFTER_DRAIN) { E(acc, cur, wr, wc, fr, fq); S.done(cur); }
        if (!has_next) break;
#pragma unroll
        for (int a = 0; a < 2; ++a)
#pragma unroll
            for (int b = 0; b < 2; ++b)
#pragma unroll
                for (int m = 0; m < 4; ++m)
#pragma unroll
                    for (int n = 0; n < 2; ++n) acc[a][b][m][n] = (f32x4){0.f, 0.f, 0.f, 0.f};
        cur = nxt; cA = nA; cB = nB; ++ui;
        if constexpr (ALIGN_EPI) { if (wr == 1) PG8_BAR; }
    }
    PG8_WAIT_V(0);
    if constexpr (!ALIGN_EPI) { if (wr == 0) PG8_BAR; }
    PG8_BAR;
    if constexpr (Epi::AFTER_DRAIN) { E.fused(acc, cur, wr, wc, fr, fq, lds, wid, lane); S.done(cur); }
#undef PG8_SA
#undef PG8_SB
#undef PG8_STAGE
#undef PG8_LDA
#undef PG8_LDB
#undef PG8_MMA
#undef PG8_WAIT_V
#undef PG8_WAIT_L
#undef PG8_BAR
#undef PG8_SCHED
}
}
#ifndef ATT_QPREP
#define ATT_QPREP 1
#endif
#ifndef ATT_VTR
#define ATT_VTR 0
#endif
constexpr int NWAVES = 8, NTHREADS = 512;
constexpr int DM = 1024, NB = 8, SEQ = 8192, CTXL = 256, NLAYER = 2, DFF = 2816, NMOD = 9;
constexpr int M_LAT = NB * SEQ, M_CTX = NB * CTXL, M_ALL = M_LAT + M_CTX;
constexpr int NKEY = SEQ + CTXL;
constexpr int NCHUNK = NKEY / 64;
constexpr int PIN = 2784, PW = 2816;
constexpr float NORM_EPS = 1e-6f, LOG2E = 1.4426950408889634f;
constexpr int NTILE64 = M_ALL / 64;

constexpr size_t MiB = 1u << 20;
constexpr size_t WS_CTL = 0, CTL_ZERO_BYTES = 1 * MiB;
constexpr size_t WS_MODV = 1 * MiB;
constexpr size_t WS_ROPE = 1 * MiB + 768 * 1024;
constexpr size_t WS_RWWT = 1 * MiB + 800 * 1024;
constexpr size_t WS_W13 = 2 * MiB;
constexpr size_t WS_W2 = 46 * MiB;
constexpr size_t WS_WIN = 68 * MiB;
constexpr size_t WS_WOUT = 79 * MiB;
constexpr size_t WS_XC = 84 * MiB;
constexpr size_t WS_KC = 92 * MiB;
constexpr size_t WS_VT = 125 * MiB;
constexpr size_t WS_GLAS = 158 * MiB;
constexpr size_t WS_HO = 228 * MiB;
constexpr size_t WS_Y = 360 * MiB;
constexpr size_t WS_UP = 492 * MiB;
constexpr size_t WS_RW = 855 * MiB;
constexpr size_t WS_END = 1024 * MiB;
constexpr size_t SZ_ROWS256 = (size_t)M_ALL * 256 * 2;
static_assert(WS_ROPE + 192 * 16 * 2 * 4 <= WS_RWWT && WS_RWWT + 2 * 49152 * 2 <= WS_W13, "ws map 0");
static_assert(WS_W13 + (size_t)4 * 5632 * 1024 * 2 <= WS_W2 && WS_W2 + (size_t)4 * 1024 * 2816 * 2 <= WS_WIN && WS_WIN + (size_t)2 * 2816 * 1024 * 2 <= WS_WOUT && WS_WOUT + (size_t)2 * 1024 * 1024 * 2 <= WS_XC, "ws map 1");
static_assert(WS_XC + (size_t)M_CTX * 1024 * 4 <= WS_KC && WS_KC + (size_t)NB * 4 * NKEY * 64 * 2 <= WS_VT && WS_VT + (size_t)NB * 4 * NKEY * 64 * 2 <= WS_GLAS, "ws map 2");
static_assert(WS_GLAS + (size_t)32 * 2 * NCHUNK * 2112 * 4 <= WS_HO && WS_HO + (size_t)M_ALL * 1024 * 2 <= WS_Y && WS_Y + (size_t)M_ALL * 1024 * 2 <= WS_UP, "ws map 3");
static_assert(WS_KC + (size_t)M_LAT * 1024 * 2 <= WS_HO, "parked residual");
static_assert(WS_UP + (size_t)M_ALL * PW * 2 <= WS_RW && WS_RW + 5 * SZ_ROWS256 <= WS_END && 4 * SZ_ROWS256 <= (size_t)M_ALL * 1024 * 2, "ws map 4");
constexpr int CW_BAR = 4096;
constexpr int CW_QUEUE = 16384;

enum { PT_GLA_QK = 0, PT_GLA_V = 1, PT_GLA_G = 2, PT_SWA_Q = 3, PT_SWA_KV = 4, PT_FA_Q = 5, PT_FA_KV = 6, PT_RW_R = 7, PT_RW_K = 8, PT_RW_V = 9, PT_LOW = 10 };
enum { RA_R = 0, RA_V = 1, RA_K = 2, RA_NKK = 3, RA_AF = 4, RA_AB = 5, RA_EF = 6, RA_EB = 7, RA_G = 8 };

constexpr int RING_OFF = 0, RING_BYTES = 131072;
constexpr int LDSCTL_OFF = RING_BYTES, MISC_OFF = LDSCTL_OFF + 320;
constexpr int LDS_BYTES = 147456;

#define GAS __attribute__((address_space(1)))
#define LAS __attribute__((address_space(3)))
typedef unsigned short bf16;
typedef unsigned v4u __attribute__((ext_vector_type(4)));
typedef unsigned v2u __attribute__((ext_vector_type(2)));
typedef float f32x4 __attribute__((ext_vector_type(4)));
typedef float f32x16 __attribute__((ext_vector_type(16)));
typedef short bf16x8 __attribute__((ext_vector_type(8)));
typedef GAS unsigned gu32;
#define RLX_AGENT __ATOMIC_RELAXED, __HIP_MEMORY_SCOPE_AGENT
#define LDS_WAIT() asm volatile("s_waitcnt lgkmcnt(0)" ::: "memory")
#define VM_WAIT() asm volatile("s_waitcnt vmcnt(0)" ::: "memory")
__device__ __forceinline__ unsigned f2bf(float f) { unsigned u = __builtin_bit_cast(unsigned, f); return (u + 0x7fffu + ((u >> 16) & 1u)) >> 16; }
__device__ __forceinline__ unsigned pk2(float lo, float hi) { return f2bf(lo) | (f2bf(hi) << 16); }
__device__ __forceinline__ float bflo(unsigned w) { return __uint_as_float(w << 16); }
__device__ __forceinline__ float bfhi(unsigned w) { return __uint_as_float(w & 0xffff0000u); }
__device__ __forceinline__ float bf1(bf16 v) { return __uint_as_float((unsigned)v << 16); }
__device__ __forceinline__ float fexp2(float x) { return __builtin_amdgcn_exp2f(x); }
__device__ __forceinline__ float fexp(float x) { return __builtin_amdgcn_exp2f(x * LOG2E); }
__device__ __forceinline__ float frcp(float x) { return __builtin_amdgcn_rcpf(x); }
__device__ __forceinline__ float fsigmoid(float x) { return frcp(1.0f + fexp(-x)); }
__device__ __forceinline__ float wave_sum(float v) {
#pragma unroll
    for (int o = 1; o < 64; o <<= 1) v += __shfl_xor(v, o);
    return v;
}
__device__ __forceinline__ float red8(float v) { v += __shfl_xor(v, 1); v += __shfl_xor(v, 2); v += __shfl_xor(v, 4); return v; }
typedef float f32x2_t __attribute__((ext_vector_type(2))); typedef __bf16 bf16x2_t __attribute__((ext_vector_type(2)));
__device__ __forceinline__ unsigned cvtpk(float lo, float hi) { f32x2_t v = {lo, hi}; bf16x2_t b = __builtin_convertvector(v, bf16x2_t); return __builtin_bit_cast(unsigned, b); }
#define DPP_F(v, ctrl) __int_as_float(__builtin_amdgcn_update_dpp(0, __float_as_int(v), (ctrl), 0xf, 0xf, true))
__device__ __forceinline__ float red8_dpp(float v) {
    v += DPP_F(v, 0x141);
    v += DPP_F(v, 0xB1);
    v += DPP_F(v, 0x4E);
    return v;
}
__device__ __forceinline__ float xor2_dpp(float v) { return DPP_F(v, 0x4E); }
__device__ __forceinline__ bf16x8 tr_frag(const LAS unsigned char* buf, int rowb, int cb, int ks, int lane) {
    typedef short s4v __attribute__((ext_vector_type(4)));
    const LAS unsigned char* a = buf + (32 * ks + 8 * (lane >> 4) + ((lane & 15) >> 2)) * rowb + (16 * cb + 4 * (lane & 3)) * 2;
    const s4v t0 = __builtin_amdgcn_ds_read_tr16_b64_v4i16((LAS s4v*)a), t1 = __builtin_amdgcn_ds_read_tr16_b64_v4i16((LAS s4v*)(a + 4 * rowb));
    const v2u u0 = __builtin_bit_cast(v2u, t0), u1 = __builtin_bit_cast(v2u, t1);
    return __builtin_bit_cast(bf16x8, (v4u){u0.x, u0.y, u1.x, u1.y});
}
#define XB_TMO      128
#define XB_XCNT(j)  (256  + 64 * (j))
#define XB_XSUB(j)  (1280 + 64 * (j))
#define XB_XGEN(j)  (2304 + 64 * (j))
#define XB_TOP      3328
#define XB_TOPGEN   3392
#define XCD_BAR_WORDS 3456
#define XB_SPIN_CAP (1u << 18)

__device__ __forceinline__ unsigned xb_ld(unsigned* p)              { return __hip_atomic_load(p, __ATOMIC_RELAXED, __HIP_MEMORY_SCOPE_AGENT); }
__device__ __forceinline__ unsigned xb_add(unsigned* p, unsigned v) { return __hip_atomic_fetch_add(p, v, __ATOMIC_RELAXED, __HIP_MEMORY_SCOPE_AGENT); }
__device__ __forceinline__ unsigned xb_xcc_id() { return (unsigned)__builtin_amdgcn_s_getreg((3 << 11) | 20) & 0xFu; }
#define XB_SPIN(cond, bar) do { unsigned _sp = 0; while (cond) { __builtin_amdgcn_s_sleep(1); \
    if ((++_sp & 255u) == 0u) { if (xb_ld(&(bar)[XB_TMO])) break; if (_sp > XB_SPIN_CAP) { atomicAdd(&(bar)[XB_TMO], 1u); break; } } } } while (0)

struct XcdBarrier {
    unsigned* bar; unsigned x;
    volatile LAS unsigned* st;
};

__device__ __forceinline__ XcdBarrier xcd_barrier_post(unsigned* bar, volatile LAS unsigned* st) {
    XcdBarrier b; b.bar = bar; b.x = xb_xcc_id(); b.st = st;
    if (threadIdx.x == 0) (void)xb_add(&bar[XB_XCNT(b.x)], 1u);
    return b;
}
__device__ __forceinline__ void xcd_barrier_complete(unsigned* bar, unsigned x, unsigned& nloc, unsigned& nx) {
    const unsigned G = gridDim.x * gridDim.y * gridDim.z;
    unsigned sum, cnt, mine, sp = 0u;
    for (;;) {
        sum = 0u; cnt = 0u; mine = 0u;
#pragma unroll
        for (unsigned j = 0; j < 16; ++j) { const unsigned c = xb_ld(&bar[XB_XCNT(j)]); sum += c; cnt += (c > 0u) ? 1u : 0u; mine = (j == x) ? c : mine; }
        if (sum == G) break;
        __builtin_amdgcn_s_sleep(1);
        if ((++sp & 255u) == 0u) { if (xb_ld(&bar[XB_TMO])) break; if (sp > XB_SPIN_CAP) { atomicAdd(&bar[XB_TMO], 1u); break; } }
    }
    nloc = mine > 0u ? mine : 1u; nx = cnt > 0u ? cnt : 1u;
}

__device__ __forceinline__ void xcd_barrier(const XcdBarrier& b) {
    asm volatile("s_waitcnt vmcnt(0)" ::: "memory");
    __syncthreads();
    if (threadIdx.x == 0) {
        unsigned* bar = b.bar;
        __builtin_amdgcn_s_waitcnt(0);
        unsigned nloc = b.st[0], nx = b.st[1];
        if (nloc == 0u) { xcd_barrier_complete(bar, b.x, nloc, nx); b.st[0] = nloc; b.st[1] = nx; }
        const unsigned old = xb_add(&bar[XB_XSUB(b.x)], 1u);
        const unsigned gen = old / nloc;
        if (old + 1u == (gen + 1u) * nloc) {
            __builtin_amdgcn_fence(__ATOMIC_RELEASE, "agent");
            asm volatile("s_waitcnt vmcnt(0)" ::: "memory");
            const unsigned og = xb_add(&bar[XB_TOP], 1u);
            const unsigned tg = og / nx;
            if (og + 1u == (tg + 1u) * nx) xb_add(&bar[XB_TOPGEN], 1u);
            else XB_SPIN(xb_ld(&bar[XB_TOPGEN]) == tg, bar);
            __builtin_amdgcn_fence(__ATOMIC_ACQUIRE, "agent");
            xb_add(&bar[XB_XGEN(b.x)], 1u);
            asm volatile("s_waitcnt vmcnt(0)" ::: "memory");
        } else {
            XB_SPIN(xb_ld(&bar[XB_XGEN(b.x)]) == gen, bar);
            __builtin_amdgcn_fence(__ATOMIC_ACQUIRE, "agent");
            asm volatile("s_waitcnt vmcnt(0)" ::: "memory");
        }
    }
    __syncthreads();
}
struct Frame {
    LAS unsigned char* lds;
    volatile LAS unsigned* MISC;
    gu32* ctl;
    int tid, lane, wave;
    int vcu, G, bid;
    const float* in[28];
    float* out; unsigned char* ws;
};
enum { I_X = 0, I_C, I_CTX, I_CCTX, I_WMOD, I_BMOD, I_NORMG, I_W13, I_W2, I_WIN, I_WOUT, I_GLA_WA2, I_GLA_BA, I_GLA_ONORM, I_SWA_SINK, I_FA_QN, I_FA_KN,
       I_RW_MU, I_RW_W0, I_RW_W2, I_RW_A0, I_RW_A2, I_RW_G2, I_RW_KK, I_RW_KA, I_RW_RK, I_RW_LNW, I_RW_LNB };

__device__ __forceinline__ bf16* ptile(const Frame& F, int t) { return (bf16*)(F.ws + WS_UP) + (size_t)t * M_ALL * 256; }
__device__ __forceinline__ bf16* rwarr(const Frame& F, int a) { return (bf16*)(F.ws + (a < 4 ? WS_Y + (size_t)a * SZ_ROWS256 : WS_RW + (size_t)(a - 4) * SZ_ROWS256)); }
__device__ __forceinline__ int chunk_row0(int b, int c) { return c < 4 ? M_LAT + b * CTXL + 64 * c : b * SEQ + 64 * (c - 4); }
__device__ __forceinline__ int scan_chunk(int dir, int s) { return dir == 0 ? s : (s < 4 ? 3 - s : 135 - s); }

#ifndef P0_NT
#define P0_NT 1
#endif
#if P0_NT
#define P0_LD(p_) __builtin_nontemporal_load(p_)
#else
#define P0_LD(p_) (*(p_))
#endif
__device__ __forceinline__ void p0_transpose_item(const float* W, int K, int Nsrc, bf16* WT, int k0, int n0, int src0, LAS float* scr, int lane) {
    float tv[32];
#pragma unroll
    for (int i = 0; i < 32; ++i) { const int kk = 2 * i + (lane >> 5); tv[i] = src0 >= 0 ? P0_LD(&W[(size_t)(k0 + kk) * Nsrc + src0 + (lane & 31)]) : 0.f; }
#pragma unroll
    for (int i = 0; i < 32; ++i) { const int kk = 2 * i + (lane >> 5); scr[kk * 33 + (lane & 31)] = tv[i]; }
    LDS_WAIT(); asm volatile("" ::: "memory");
    const int c = lane & 7;
#pragma unroll
    for (int j = 0; j < 4; ++j) { const int n = (lane >> 3) + 8 * j; const LAS float* s = scr + (8 * c) * 33 + n;
        v4u o; o.x = pk2(s[0 * 33], s[1 * 33]); o.y = pk2(s[2 * 33], s[3 * 33]); o.z = pk2(s[4 * 33], s[5 * 33]); o.w = pk2(s[6 * 33], s[7 * 33]);
        *(GAS v4u*)(WT + (size_t)(n0 + n) * K + k0 + 8 * c) = o; }
    LDS_WAIT(); asm volatile("" ::: "memory");
}
__device__ __forceinline__ int win_src(int n) {
    if (n < 768) return n;
    if (n < 1280) return 800 + (n - 768);
    if (n < 1792) return 1312 + (n - 1280);
    if (n < 2560) return 1824 + (n - 1792);
    if (n < 2592) return 768 + (n - 2560);
    if (n < 2784) return n;
    return -1;
}
template <int PART>
__device__ __forceinline__ void p0_prologue(Frame& F) {
    LAS float* scr = (LAS float*)(F.lds + RING_OFF + F.wave * 16384);
    const int gw = F.vcu * NWAVES + F.wave, NGW = F.G * NWAVES;
    if constexpr (PART & 2) {
    constexpr int I13 = 16 * 176, I2 = 44 * 32, IIN = 16 * 88, IOUT = 16 * 32;
    constexpr int NIT = 4 * I13 + 4 * I2 + 2 * IIN + 2 * IOUT;
    for (int it = gw; it < NIT; it += NGW) {
        int r = it;
        if (r < 4 * I13) { const int mi = r / I13, q = r % I13, kb = q / 176, nb = q % 176, n0 = nb * 32;
            const int pn = n0 >> 8, within = n0 & 255, bj = within >> 7, j = within & 127, src0 = bj * DFF + pn * 128 + j;
            p0_transpose_item(F.in[I_W13] + (size_t)mi * DM * 2 * DFF, DM, 2 * DFF, (bf16*)(F.ws + WS_W13) + (size_t)mi * 2 * DFF * DM, kb * 64, n0, src0, scr, F.lane); continue; }
        r -= 4 * I13;
        if (r < 4 * I2) { const int mi = r / I2, q = r % I2, kb = q / 32, nb = q % 32;
            p0_transpose_item(F.in[I_W2] + (size_t)mi * DFF * DM, DFF, DM, (bf16*)(F.ws + WS_W2) + (size_t)mi * DM * DFF, kb * 64, nb * 32, nb * 32, scr, F.lane); continue; }
        r -= 4 * I2;
        if (r < 2 * IIN) { const int mi = r / IIN, q = r % IIN, kb = q / 88, nb = q % 88;
            p0_transpose_item(F.in[I_WIN] + (size_t)mi * DM * PIN, DM, PIN, (bf16*)(F.ws + WS_WIN) + (size_t)mi * PW * DM, kb * 64, nb * 32, win_src(nb * 32), scr, F.lane); continue; }
        r -= 2 * IIN;
        { const int mi = r / IOUT, q = r % IOUT, kb = q / 32, nb = q % 32;
            p0_transpose_item(F.in[I_WOUT] + (size_t)mi * DM * DM, DM, DM, (bf16*)(F.ws + WS_WOUT) + (size_t)mi * DM * DM, kb * 64, nb * 32, nb * 32, scr, F.lane); }
    }
    __syncthreads();
    }
    if constexpr (PART & 1) {
        LAS float* sc = (LAS float*)(F.lds + RING_OFF);
        LAS float* red = sc + 9 * 1024;
        for (int i = F.tid; i < 9 * 1024; i += NTHREADS) { const int mi = i >> 10, k = i & 1023; const float v = mi < 8 ? F.in[I_C][mi * 1024 + k] : F.in[I_CCTX][k]; sc[i] = v * fsigmoid(v); }
        __syncthreads();
        float* modv = (float*)(F.ws + WS_MODV);
        for (int it = F.vcu; it < 2 * 144; it += F.G) {
            const int l = it / 144, n = (it % 144) * 64 + F.lane;
            const float* wm = F.in[I_WMOD] + (size_t)l * DM * 9216 + n;
            float acc[9];
#pragma unroll
            for (int mi = 0; mi < 9; ++mi) acc[mi] = 0.f;
#pragma unroll 16
            for (int i = 0; i < 128; ++i) { const int k = F.wave + 8 * i; const float w = P0_LD(&wm[(size_t)k * 9216]);
#pragma unroll
                for (int mi = 0; mi < 9; ++mi) acc[mi] += sc[mi * 1024 + k] * w; }
#pragma unroll
            for (int mi = 0; mi < 9; ++mi) red[(F.wave * 9 + mi) * 64 + F.lane] = acc[mi];
            __syncthreads();
            for (int o = F.tid; o < 9 * 64; o += NTHREADS) { const int mi = o >> 6, c = o & 63; float s = 0.f;
#pragma unroll
                for (int w = 0; w < 8; ++w) s += red[(w * 9 + mi) * 64 + c];
                const int nn = (it % 144) * 64 + c; modv[((size_t)l * 9 + mi) * 9216 + nn] = s + F.in[I_BMOD][l * 9216 + nn]; }
            __syncthreads();
        }
    }
    if constexpr (PART & 2) {
        bf16* wt = (bf16*)(F.ws + WS_RWWT);
        for (int i = F.vcu * NTHREADS + F.tid; i < 2 * 49152; i += F.G * NTHREADS) {
            const int l = i / 49152, q = i % 49152; float v;
            if (q < 32768) { const int pq = q >> 13, ch = (q >> 5) & 255, k = q & 31; const float* src = (pq < 2 ? F.in[I_RW_W2] : F.in[I_RW_A2]) + ((size_t)(l * 2 + (pq & 1)) * 32 + k) * 256 + ch; v = *src; }
            else { const int q2 = q - 32768, ch = q2 >> 6, k = q2 & 63; v = F.in[I_RW_G2][((size_t)l * 64 + k) * 256 + ch]; }
            wt[i] = (bf16)f2bf(v);
        }
    }
    if ((PART & 2) && F.vcu == F.G - 1) {
        float* rt = (float*)(F.ws + WS_ROPE);
        for (int i = F.tid; i < 192 * 16; i += NTHREADS) { const int pos = i >> 4, j = i & 15; const float p = pos < 128 ? (float)pos : (float)(pos - 128);
            const float inv = exp2f(-(float)j * (13.287712379549449f / 16.0f)); const float ang = p * inv; float s, c; sincosf(ang, &s, &c); rt[2 * i] = c; rt[2 * i + 1] = s; }
    }
}

#ifndef THIN_NT
#define THIN_NT 1
#endif
#ifndef THIN_H_NT
#define THIN_H_NT 0
#endif
#if THIN_H_NT
#define THIN_H_ST(v_, p_) __builtin_nontemporal_store(v_, p_)
#else
#define THIN_H_ST(v_, p_) (*(p_) = (v_))
#endif
#ifndef THIN_X_NT
#define THIN_X_NT 1
#endif
#if THIN_X_NT
#define THIN_X_LD(p_) __builtin_nontemporal_load(p_)
#else
#define THIN_X_LD(p_) (*(p_))
#endif
#ifndef THIN_Y_NT
#define THIN_Y_NT 1
#endif
#if THIN_Y_NT
#define THIN_Y_LD(p_) __builtin_nontemporal_load(p_)
#else
#define THIN_Y_LD(p_) (*(p_))
#endif
#if THIN_NT
#define THIN_NT_LD(p_) __builtin_nontemporal_load(p_)
#define THIN_NT_ST(v_, p_) __builtin_nontemporal_store(v_, p_)
#else
#define THIN_NT_LD(p_) (*(p_))
#define THIN_NT_ST(v_, p_) (*(p_) = (v_))
#endif
template <bool HAS_RES, bool HAS_NEXT, bool XIN_BF = false, bool XOUT_BF = false>
__device__ __forceinline__ void thin_phase(Frame& F, const bf16* aY, const void* xsrc_lat, const float* xsrc_ctx, void* xdst_lat, float* xdst_ctx,
                                           const float* gpost, const float* gate  , float coef,
                                           const float* gpre, const float* shiftv, const float* scalev  , bf16* aH, int nrows) {
    const int gw = F.vcu * NWAVES + F.wave, NGW = F.G * NWAVES;
    const int per = (nrows + NGW - 1) / NGW; const int r0 = gw * per, r1 = min(nrows, r0 + per);
    f32x4 cg[4], sc[4], sh[4]; int cur_mi = -1;
    f32x4 xnA[4], xnB[4]; v2u xnbA[4], xnbB[4], ynA[4], ynB[4];
#define THIN_LOAD(XN, XNB, YN, r_) do { const int rr_ = (r_); \
        if (XIN_BF && rr_ < M_LAT) { const bf16* xs_ = (const bf16*)xsrc_lat + (size_t)rr_ * DM; \
            _Pragma("unroll") for (int j = 0; j < 4; ++j) XNB[j] = THIN_X_LD((const v2u*)(xs_ + 4 * F.lane + 256 * j)); } \
        else { const float* xs_ = rr_ < M_LAT ? (const float*)xsrc_lat + (size_t)rr_ * DM : xsrc_ctx + (size_t)(rr_ - M_LAT) * DM; \
            _Pragma("unroll") for (int j = 0; j < 4; ++j) XN[j] = THIN_X_LD((const f32x4*)(xs_ + 4 * F.lane + 256 * j)); } \
        if (HAS_RES) { _Pragma("unroll") for (int j = 0; j < 4; ++j) YN[j] = THIN_Y_LD((const v2u*)(aY + (size_t)rr_ * DM + 4 * F.lane + 256 * j)); } } while (0)
#define THIN_ROW(XN, XNB, YN, r_) do { const int r = (r_); \
        const int mi = r < M_LAT ? (r >> 13) : 8; \
        if (mi != cur_mi) { cur_mi = mi; \
            _Pragma("unroll") for (int j = 0; j < 4; ++j) { const int c = 4 * F.lane + 256 * j; \
                if (HAS_RES) { const f32x4 g = *(const f32x4*)(gate + (size_t)mi * 9216 + c), p = *(const f32x4*)(gpost + c); cg[j] = g * p * coef; } \
                if (HAS_NEXT) { const f32x4 s = *(const f32x4*)(scalev + (size_t)mi * 9216 + c), p = *(const f32x4*)(gpre + c); sc[j] = p * (s + 1.0f); \
                    sh[j] = *(const f32x4*)(shiftv + (size_t)mi * 9216 + c); } } } \
        f32x4 x[4]; v2u yw[4]; \
        if (XIN_BF && r < M_LAT) { _Pragma("unroll") for (int j = 0; j < 4; ++j) { const v2u w = XNB[j]; x[j] = (f32x4){bflo(w.x), bfhi(w.x), bflo(w.y), bfhi(w.y)}; } } \
        else { _Pragma("unroll") for (int j = 0; j < 4; ++j) x[j] = XN[j]; } \
        _Pragma("unroll") for (int j = 0; j < 4; ++j) { if (HAS_RES) yw[j] = YN[j]; } \
        if (r + 2 < r1) THIN_LOAD(XN, XNB, YN, r + 2); \
        if (HAS_RES) { \
            f32x4 y[4]; float s = 0.f; \
            _Pragma("unroll") for (int j = 0; j < 4; ++j) { const v2u w = yw[j]; y[j] = (f32x4){bflo(w.x), bfhi(w.x), bflo(w.y), bfhi(w.y)}; \
                s += (y[j].x * y[j].x + y[j].y * y[j].y) + (y[j].z * y[j].z + y[j].w * y[j].w); } \
            const float rstd = 1.0f / sqrtf(wave_sum(s) * (1.0f / DM) + NORM_EPS); \
            _Pragma("unroll") for (int j = 0; j < 4; ++j) x[j] = x[j] + cg[j] * (y[j] * rstd); \
            if (XOUT_BF && r < M_LAT) { bf16* xd = (bf16*)xdst_lat + (size_t)r * DM; \
                _Pragma("unroll") for (int j = 0; j < 4; ++j) { v2u w; w.x = cvtpk(x[j].x, x[j].y); w.y = cvtpk(x[j].z, x[j].w); THIN_NT_ST(w, (v2u*)(xd + 4 * F.lane + 256 * j)); } \
            } else { float* xd = r < M_LAT ? (float*)xdst_lat + (size_t)r * DM : xdst_ctx + (size_t)(r - M_LAT) * DM; \
                _Pragma("unroll") for (int j = 0; j < 4; ++j) THIN_NT_ST(x[j], (f32x4*)(xd + 4 * F.lane + 256 * j)); \
            } \
        } \
        if (HAS_NEXT) { \
            float s = 0.f; \
            _Pragma("unroll") for (int j = 0; j < 4; ++j) s += (x[j].x * x[j].x + x[j].y * x[j].y) + (x[j].z * x[j].z + x[j].w * x[j].w); \
            const float rstd = 1.0f / sqrtf(wave_sum(s) * (1.0f / DM) + NORM_EPS); \
            _Pragma("unroll") for (int j = 0; j < 4; ++j) { const f32x4 h = (x[j] * rstd) * sc[j] + sh[j]; v2u w; w.x = pk2(h.x, h.y); w.y = pk2(h.z, h.w); \
                THIN_H_ST(w, (v2u*)(aH + (size_t)r * DM + 4 * F.lane + 256 * j)); } \
        } } while (0)
    if (r0 < r1) THIN_LOAD(xnA, xnbA, ynA, r0);
    if (r0 + 1 < r1) THIN_LOAD(xnB, xnbB, ynB, r0 + 1);
    for (int rb = r0; rb < r1; rb += 2) {
        THIN_ROW(xnA, xnbA, ynA, rb);
        if (rb + 1 < r1) THIN_ROW(xnB, xnbB, ynB, rb + 1);
    }
#undef THIN_ROW
#undef THIN_LOAD
}
#ifndef M1_NT
#define M1_NT 1
#endif
#if M1_NT
#define M1_NT_LD(p_) __builtin_nontemporal_load(p_)
#define M1_NT_ST(v_, p_) (*(p_) = (v_))
#else
#define M1_NT_LD(p_) (*(p_))
#define M1_NT_ST(v_, p_) (*(p_) = (v_))
#endif
struct LayerW {
    const float *gla_wa2, *gla_ba, *gla_onorm, *swa_sink, *fa_qn, *fa_kn;
    const float *rw_mu, *rw_w0, *rw_w2, *rw_a0, *rw_a2, *rw_g2, *rw_kk, *rw_ka, *rw_rk, *rw_lnw, *rw_lnb;
};
__device__ __forceinline__ LayerW layer_w(const Frame& F, int l) {
    LayerW W;
    W.gla_wa2 = F.in[I_GLA_WA2] + (size_t)l * 2 * 16 * 128; W.gla_ba = F.in[I_GLA_BA] + l * 2 * 128; W.gla_onorm = F.in[I_GLA_ONORM] + l * 64;
    W.swa_sink = F.in[I_SWA_SINK] + l * 4; W.fa_qn = F.in[I_FA_QN] + l * 64; W.fa_kn = F.in[I_FA_KN] + l * 64;
    W.rw_mu = F.in[I_RW_MU] + (size_t)l * 2 * 960; W.rw_w0 = F.in[I_RW_W0] + l * 2 * 256; W.rw_w2 = F.in[I_RW_W2] + (size_t)l * 2 * 32 * 256;
    W.rw_a0 = F.in[I_RW_A0] + l * 2 * 256; W.rw_a2 = F.in[I_RW_A2] + (size_t)l * 2 * 32 * 256; W.rw_g2 = F.in[I_RW_G2] + (size_t)l * 64 * 256;
    W.rw_kk = F.in[I_RW_KK] + l * 256; W.rw_ka = F.in[I_RW_KA] + l * 256; W.rw_rk = F.in[I_RW_RK] + l * 256; W.rw_lnw = F.in[I_RW_LNW] + l * 256; W.rw_lnb = F.in[I_RW_LNB] + l * 256;
    return W;
}
#define UNPK4(q_) {bflo(q_.x), bfhi(q_.x), bflo(q_.y), bfhi(q_.y), bflo(q_.z), bfhi(q_.z), bflo(q_.w), bfhi(q_.w)}
__device__ __forceinline__ int opaque0() { int z; asm volatile("s_mov_b32 %0, 0" : "=s"(z)); return z; }
__device__ __forceinline__ void tile_info(int tt, int& row0, int& b, int& key0, int& t0, bool& lat) {
    if (tt < 1024) { b = tt >> 7; t0 = (tt & 127) * 64; row0 = b * SEQ + t0; key0 = t0; lat = true; }
    else { const int cc = tt - 1024; b = cc >> 2; t0 = (cc & 3) * 64; row0 = M_LAT + b * CTXL + t0; key0 = SEQ + t0; lat = false; }
}

constexpr int ROPE_LDS_OFF = RING_OFF + 40960;
__device__ __forceinline__ void rope_stage(Frame& F) {
    const f32x4* src = (const f32x4*)(F.ws + WS_ROPE) + opaque0(); LAS f32x4* dst = (LAS f32x4*)(F.lds + ROPE_LDS_OFF);
#pragma unroll
    for (int q = 0; q < 3; ++q) dst[q * NTHREADS + F.tid] = src[q * NTHREADS + F.tid];
    __syncthreads();
}
__device__ __forceinline__ void attn_prep_tile(Frame& F, const LayerW& W, int tt, int rep = 0) {
    int row0, b, key0, t0; bool lat; tile_info(tt, row0, b, key0, t0, lat);
    const int tok8 = F.tid >> 6, slot = (F.tid >> 3) & 7, s = F.tid & 7;
    const LAS float* ropeL = (const LAS float*)(F.lds + ROPE_LDS_OFF);
    const int mix = slot >> 2, isv = (slot >> 1) & 1, hh = slot & 1;
    const bf16* src0 = ptile(F, mix ? PT_FA_KV : PT_SWA_KV) + (isv ? 128 : 0) + hh * 64 + 8 * s;
    bf16* dst0 = (bf16*)(F.ws + (isv ? WS_VT : WS_KC)) + ((size_t)((b * 2 + mix) * 2 + hh) * NKEY + key0) * 64 + 8 * s;
    float gain[8];
    { const float* gq = W.fa_kn + opaque0();
#pragma unroll
      for (int e = 0; e < 8; ++e) gain[e] = mix ? gq[8 * s + e] : 1.0f; }
    (void)rep;
    v4u win[8];
#pragma unroll
    for (int u2 = 0; u2 < 8; ++u2) win[u2] = M1_NT_LD((const v4u*)(src0 + ((size_t)row0 + u2 * 8 + tok8) * 256));
#pragma unroll
    for (int u2 = 0; u2 < 8; ++u2) {
        const int tk = u2 * 8 + tok8;
        const v4u w = win[u2];
#if ATT_VTR
        if (isv) { *(v4u*)(dst0 + (size_t)tk * 64) = w; continue; }
#else
        if (isv) { const unsigned ww[4] = {w.x, w.y, w.z, w.w}; LAS bf16* vtb = (LAS bf16*)(F.lds + RING_OFF);
#pragma unroll
            for (int e = 0; e < 8; ++e) vtb[((mix * 2 + hh) * 64 + 8 * s + e) * 72 + (tk ^ (s << 3))] = (bf16)((e & 1) ? (ww[e >> 1] >> 16) : (ww[e >> 1] & 0xffffu));
            continue; }
#endif
        float x[8] = {bflo(w.x), bfhi(w.x), bflo(w.y), bfhi(w.y), bflo(w.z), bfhi(w.z), bflo(w.w), bfhi(w.w)};
        if (mix) {
            float ss = 0.f;
#pragma unroll
            for (int e = 0; e < 8; ++e) ss += x[e] * x[e];
            ss = red8_dpp(ss); const float rstd = __builtin_amdgcn_rsqf(ss * (1.0f / 64.0f) + NORM_EPS);
#pragma unroll
            for (int e = 0; e < 8; ++e) x[e] = x[e] * rstd * gain[e];
        }
        float y[8];
        if (lat) {
            const LAS float* tab = ropeL + ((s < 4) ? (t0 >> 6) * 32 : 128 * 32 + tk * 32) + 16 * (s & 1);
            const f32x4 c0 = *(const LAS f32x4*)tab, c1 = *(const LAS f32x4*)(tab + 4), c2 = *(const LAS f32x4*)(tab + 8), c3 = *(const LAS f32x4*)(tab + 12);
            const float cs[16] = {c0.x, c0.y, c0.z, c0.w, c1.x, c1.y, c1.z, c1.w, c2.x, c2.y, c2.z, c2.w, c3.x, c3.y, c3.z, c3.w};
            const float sgn = (s & 2) ? 1.0f : -1.0f;
#pragma unroll
            for (int e = 0; e < 8; ++e) { const float pr = xor2_dpp(x[e]); y[e] = x[e] * cs[2 * e] + sgn * pr * cs[2 * e + 1]; }
        } else {
#pragma unroll
            for (int e = 0; e < 8; ++e) y[e] = x[e];
        }
        v4u o; o.x = cvtpk(y[0], y[1]); o.y = cvtpk(y[2], y[3]); o.z = cvtpk(y[4], y[5]); o.w = cvtpk(y[6], y[7]);
        *(v4u*)(dst0 + (size_t)tk * 64) = o;
    }
#if !ATT_VTR
    __syncthreads();
    {
        LAS bf16* vtb = (LAS bf16*)(F.lds + RING_OFF);
        const int rw = F.tid >> 1, half = F.tid & 1, combo = rw >> 6, d = rw & 63;
        bf16* VT = (bf16*)(F.ws + WS_VT) + ((size_t)(b * 4 + combo) * 64 + d) * NKEY + key0 + half * 32;
#pragma unroll
        for (int q = 0; q < 4; ++q) *(v4u*)(VT + 8 * q) = *(const LAS v4u*)(vtb + (combo * 64 + d) * 72 + (((half * 4 + q) ^ ((d >> 3) & 7)) << 3));
    }
    __syncthreads();
#endif
}

__device__ __forceinline__ void rw_expand(const LAS float* LOW, LAS float* ZP, const float* wsrc, float bias, float osc, int lowoff, bf16* dst, int mode, int row0, int par, int c) {
    float w[32];
    int zero; asm volatile("s_mov_b32 %0, 0" : "=s"(zero));
    wsrc += zero;
#pragma unroll
    for (int j = 0; j < 32; ++j) w[j] = wsrc[(size_t)j * 256];
#pragma unroll 1
    for (int i = 0; i < 32; ++i) {
        const int tk = 2 * i + par; const size_t row = (size_t)row0 + tk; const LAS float* lp = LOW + tk * 192 + lowoff;
        float z = mode == 2 ? ZP[tk * 256 + c] : bias;
#pragma unroll
        for (int q = 0; q < 8; ++q) { const f32x4 v = *(const LAS f32x4*)(lp + 4 * q); z += v.x * w[4 * q] + v.y * w[4 * q + 1] + v.z * w[4 * q + 2] + v.w * w[4 * q + 3]; }
        if (mode == 1) ZP[tk * 256 + c] = z;
        else dst[row * 256 + c] = (bf16)f2bf(mode == 0 ? osc * fsigmoid(z) : z);
    }
}
__device__ __forceinline__ void rwkv_base_stream(Frame& F, const LayerW& W) {
    const int oz = opaque0();
    const float* mu0 = W.rw_mu + oz, *mu1 = W.rw_mu + 960 + oz;
    const int hwi = (F.vcu * NWAVES + F.wave) * 2 + (F.lane >> 5), NHW = F.G * NWAVES * 2, hc = F.lane & 31, c0 = hc * 8;
    const int per = (M_ALL + NHW - 1) / NHW, rbeg = hwi * per, rend = min(M_ALL, rbeg + per);
    const bf16* pr = ptile(F, PT_RW_R) + c0; const bf16* pk = ptile(F, PT_RW_K) + c0; const bf16* pv = ptile(F, PT_RW_V) + c0;
    bf16* oR = rwarr(F, RA_R) + c0; bf16* oV = rwarr(F, RA_V) + c0; bf16* oK = rwarr(F, RA_K) + c0; bf16* oN = rwarr(F, RA_NKK) + c0;
    float kkc[8], m0r[8], m1r[8], m0k[8], m1k[8], m0v[8], m1v[8];
#pragma unroll
    for (int e = 0; e < 8; ++e) { kkc[e] = (W.rw_kk + oz)[c0 + e]; m0r[e] = mu0[c0 + e]; m1r[e] = mu1[c0 + e]; m0k[e] = mu0[256 + c0 + e]; m1k[e] = mu1[256 + c0 + e]; m0v[e] = mu0[512 + c0 + e]; m1v[e] = mu1[512 + c0 + e]; }
    const v4u z4 = (v4u){0, 0, 0, 0};
    v4u rA = z4, kA = z4, vA = z4, rB = z4, kB = z4, vB = z4, rC = z4, kC = z4, vC = z4, rD = z4, kD = z4, vD = z4;
#define RB_LOAD(R_, K_, V_, row_) do { const int rr_ = (row_); if (rr_ >= 0 && rr_ < M_ALL) { const size_t o_ = (size_t)rr_ * 256; R_ = *(const v4u*)(pr + o_); K_ = *(const v4u*)(pk + o_); V_ = *(const v4u*)(pv + o_); } } while (0)
#define RB_STEP(row_, RP, KP, VP, RC_, KC_, VC_, RN, KN, VN, RNN, KNN, VNN) do { const int rw_ = (row_); \
        if (rw_ < rend) { \
        RB_LOAD(RNN, KNN, VNN, rw_ + 2); \
        const int t = rw_ < M_LAT ? (rw_ & (SEQ - 1)) : ((rw_ - M_LAT) & (CTXL - 1)); const bool hp = t > 0, hn = t < (rw_ < M_LAT ? SEQ : CTXL) - 1; \
        const v4u rp4 = hp ? RP : z4, kp4 = hp ? KP : z4, vp4 = hp ? VP : z4, rn4 = hn ? RN : z4, kn4 = hn ? KN : z4, vn4 = hn ? VN : z4; \
        const float rc[8] = UNPK4(RC_), kc[8] = UNPK4(KC_), vc[8] = UNPK4(VC_), rp[8] = UNPK4(rp4), kp[8] = UNPK4(kp4), vp[8] = UNPK4(vp4), rn[8] = UNPK4(rn4), kn[8] = UNPK4(kn4), vn[8] = UNPK4(vn4); \
        float rs[8], ks[8], vs[8], kr[8], ss = 0.f; \
        _Pragma("unroll") for (int e = 0; e < 8; ++e) { rs[e] = rc[e] + m0r[e] * (rp[e] - rc[e]) + m1r[e] * (rn[e] - rc[e]); ks[e] = kc[e] + m0k[e] * (kp[e] - kc[e]) + m1k[e] * (kn[e] - kc[e]); \
            vs[e] = vc[e] + m0v[e] * (vp[e] - vc[e]) + m1v[e] * (vn[e] - vc[e]); kr[e] = ks[e] * kkc[e]; ss += kr[e] * kr[e]; } \
        ss = red8_dpp(ss); const float nrm = -1.0f / sqrtf(fmaxf(ss, 1e-24f)); \
        const size_t off = (size_t)rw_ * 256; v4u o; \
        o.x = cvtpk(rs[0], rs[1]); o.y = cvtpk(rs[2], rs[3]); o.z = cvtpk(rs[4], rs[5]); o.w = cvtpk(rs[6], rs[7]); *(v4u*)(oR + off) = o; \
        o.x = cvtpk(vs[0], vs[1]); o.y = cvtpk(vs[2], vs[3]); o.z = cvtpk(vs[4], vs[5]); o.w = cvtpk(vs[6], vs[7]); *(v4u*)(oV + off) = o; \
        o.x = cvtpk(ks[0], ks[1]); o.y = cvtpk(ks[2], ks[3]); o.z = cvtpk(ks[4], ks[5]); o.w = cvtpk(ks[6], ks[7]); *(v4u*)(oK + off) = o; \
        o.x = cvtpk(kr[0] * nrm, kr[1] * nrm); o.y = cvtpk(kr[2] * nrm, kr[3] * nrm); o.z = cvtpk(kr[4] * nrm, kr[5] * nrm); o.w = cvtpk(kr[6] * nrm, kr[7] * nrm); *(v4u*)(oN + off) = o; } } while (0)
    if (rbeg < rend) { RB_LOAD(rA, kA, vA, rbeg - 1); RB_LOAD(rB, kB, vB, rbeg); RB_LOAD(rC, kC, vC, rbeg + 1); }
    for (int row = rbeg; row < rend; row += 4) {
        RB_STEP(row,     rA, kA, vA, rB, kB, vB, rC, kC, vC, rD, kD, vD);
        RB_STEP(row + 1, rB, kB, vB, rC, kC, vC, rD, kD, vD, rA, kA, vA);
        RB_STEP(row + 2, rC, kC, vC, rD, kD, vD, rA, kA, vA, rB, kB, vB);
        RB_STEP(row + 3, rD, kD, vD, rA, kA, vA, rB, kB, vB, rC, kC, vC);
    }
#undef RB_LOAD
#undef RB_STEP
}
#ifndef RW_BASE_IN_TILE
#define RW_BASE_IN_TILE 1
#endif
#ifndef RWP_VAR
#define RWP_VAR 0
#endif
__device__ __forceinline__ void rwkv_prep_tile(Frame& F, const LayerW& W, int tt, int lyr, int rep = 0) {
    int row0, b, key0, t0; bool lat; tile_info(tt, row0, b, key0, t0, lat);
    const int seqlen = lat ? SEQ : CTXL;
    LAS bf16* LOWB = (LAS bf16*)(F.lds + RING_OFF);
    const int oz = opaque0();
    const float* mu0 = W.rw_mu + oz, *mu1 = W.rw_mu + 960 + oz;
    if (!((RWP_VAR & 1) && rep)) {
        const int tk = F.tid >> 3, cg = F.tid & 7; const int t = t0 + tk; const size_t row = (size_t)row0 + tk;
        const bf16* lt = ptile(F, PT_LOW) + row * 256 + 32 + cg * 24;
        const float* mp = mu0 + 768 + cg * 24; const float* mn = mu1 + 768 + cg * 24; LAS bf16* lw = LOWB + tk * 200 + cg * 24;
        const bool hp = t > 0, hn = t < seqlen - 1;
#pragma unroll
        for (int q = 0; q < 3; ++q) {
            const v4u wc = *(const v4u*)(lt + q * 8);
            v4u wp = (v4u){0, 0, 0, 0}, wn = (v4u){0, 0, 0, 0};
            if (hp) wp = *(const v4u*)(lt - 256 + q * 8);
            if (hn) wn = *(const v4u*)(lt + 256 + q * 8);
            const float c[8] = {bflo(wc.x), bfhi(wc.x), bflo(wc.y), bfhi(wc.y), bflo(wc.z), bfhi(wc.z), bflo(wc.w), bfhi(wc.w)};
            const float p[8] = {bflo(wp.x), bfhi(wp.x), bflo(wp.y), bfhi(wp.y), bflo(wp.z), bfhi(wp.z), bflo(wp.w), bfhi(wp.w)};
            const float n[8] = {bflo(wn.x), bfhi(wn.x), bflo(wn.y), bfhi(wn.y), bflo(wn.z), bfhi(wn.z), bflo(wn.w), bfhi(wn.w)};
            const int j0 = cg * 24 + q * 8;
            float v[8];
#pragma unroll
            for (int e = 0; e < 8; ++e) v[e] = c[e] + mp[q * 8 + e] * (p[e] - c[e]) + mn[q * 8 + e] * (n[e] - c[e]);
            if (j0 < 64) {
#pragma unroll
                for (int e = 0; e < 8; ++e) v[e] = 1.0f - 2.0f * frcp(1.0f + fexp(2.0f * v[e]));
            } else if (j0 >= 128) {
#pragma unroll
                for (int e = 0; e < 8; ++e) v[e] = fsigmoid(v[e]);
            }
            *(LAS v4u*)(lw + q * 8) = (v4u){cvtpk(v[0], v[1]), cvtpk(v[2], v[3]), cvtpk(v[4], v[5]), cvtpk(v[6], v[7])};
        }
    }
    __syncthreads();
    const int h = F.wave & 3, par = F.wave >> 2, c = h * 64 + F.lane;
    bf16* pr = ptile(F, PT_RW_R); bf16* pk = ptile(F, PT_RW_K); bf16* pv = ptile(F, PT_RW_V);
    if (RW_BASE_IN_TILE && !((RWP_VAR & 2) && rep)) {
        const int hc = F.tid & 31, c0 = hc * 8;
        float kkc[8], m0r[8], m1r[8], m0k[8], m1k[8], m0v[8], m1v[8];
#pragma unroll
        for (int e = 0; e < 8; ++e) { kkc[e] = (W.rw_kk + oz)[c0 + e]; m0r[e] = mu0[c0 + e]; m1r[e] = mu1[c0 + e]; m0k[e] = mu0[256 + c0 + e]; m1k[e] = mu1[256 + c0 + e]; m0v[e] = mu0[512 + c0 + e]; m1v[e] = mu1[512 + c0 + e]; }
#pragma unroll 2
        for (int q = 0; q < 4; ++q) {
            const int tk = q * 16 + (F.tid >> 5), t = t0 + tk; const size_t off = ((size_t)row0 + tk) * 256 + c0; const bool hp = t > 0, hn = t < seqlen - 1;
            const v4u z4 = (v4u){0, 0, 0, 0};
            const v4u rc4 = *(const v4u*)(pr + off), kc4 = *(const v4u*)(pk + off), vc4 = *(const v4u*)(pv + off);
            const v4u rp4 = hp ? *(const v4u*)(pr + off - 256) : z4, kp4 = hp ? *(const v4u*)(pk + off - 256) : z4, vp4 = hp ? *(const v4u*)(pv + off - 256) : z4;
            const v4u rn4 = hn ? *(const v4u*)(pr + off + 256) : z4, kn4 = hn ? *(const v4u*)(pk + off + 256) : z4, vn4 = hn ? *(const v4u*)(pv + off + 256) : z4;
            const float rc[8] = UNPK4(rc4), kc[8] = UNPK4(kc4), vc[8] = UNPK4(vc4), rp[8] = UNPK4(rp4), kp[8] = UNPK4(kp4), vp[8] = UNPK4(vp4), rn[8] = UNPK4(rn4), kn[8] = UNPK4(kn4), vn[8] = UNPK4(vn4);
            float rs[8], ks[8], vs[8], kr[8], ss = 0.f;
#pragma unroll
            for (int e = 0; e < 8; ++e) { rs[e] = rc[e] + m0r[e] * (rp[e] - rc[e]) + m1r[e] * (rn[e] - rc[e]); ks[e] = kc[e] + m0k[e] * (kp[e] - kc[e]) + m1k[e] * (kn[e] - kc[e]);
                vs[e] = vc[e] + m0v[e] * (vp[e] - vc[e]) + m1v[e] * (vn[e] - vc[e]); kr[e] = ks[e] * kkc[e]; ss += kr[e] * kr[e]; }
            ss = red8_dpp(ss); const float nrm = -1.0f / sqrtf(fmaxf(ss, 1e-24f));
            v4u o;
            o.x = cvtpk(rs[0], rs[1]); o.y = cvtpk(rs[2], rs[3]); o.z = cvtpk(rs[4], rs[5]); o.w = cvtpk(rs[6], rs[7]); M1_NT_ST(o, (v4u*)(rwarr(F, RA_R) + off));
            o.x = cvtpk(vs[0], vs[1]); o.y = cvtpk(vs[2], vs[3]); o.z = cvtpk(vs[4], vs[5]); o.w = cvtpk(vs[6], vs[7]); M1_NT_ST(o, (v4u*)(rwarr(F, RA_V) + off));
            o.x = cvtpk(ks[0], ks[1]); o.y = cvtpk(ks[2], ks[3]); o.z = cvtpk(ks[4], ks[5]); o.w = cvtpk(ks[6], ks[7]); M1_NT_ST(o, (v4u*)(rwarr(F, RA_K) + off));
            o.x = cvtpk(kr[0] * nrm, kr[1] * nrm); o.y = cvtpk(kr[2] * nrm, kr[3] * nrm); o.z = cvtpk(kr[4] * nrm, kr[5] * nrm); o.w = cvtpk(kr[6] * nrm, kr[7] * nrm); M1_NT_ST(o, (v4u*)(rwarr(F, RA_NKK) + off));
        }
    }
    if (!((RWP_VAR & 4) && rep)) {
        const int l15 = F.lane & 15, l4 = F.lane >> 4, w = F.wave;
        const bf16* wt = (const bf16*)(F.ws + WS_RWWT) + (size_t)lyr * 49152 + opaque0();
        const LAS unsigned char* lowp = (const LAS unsigned char*)LOWB + l15 * 400 + 16 * l4;
#pragma unroll 1
        for (int pq = 0; pq < 5; ++pq) {
            const int K = pq < 4 ? 32 : 64, colb = pq < 4 ? pq * 32 : 128;
            const bf16* wp = wt + (pq < 4 ? pq * 8192 : 32768);
            bf16* dst = rwarr(F, pq == 0 ? RA_EF : pq == 1 ? RA_EB : pq == 2 ? RA_AF : pq == 3 ? RA_AB : RA_G);
            if (RWP_VAR && rep) dst = (bf16*)(F.ws + WS_HO + (size_t)(pq & 3) * SZ_ROWS256);
            const float* bsrc = pq < 2 ? W.rw_w0 + pq * 256 : W.rw_a0 + (pq & 1) * 256;
            bf16x8 a0[2], a1[2]; f32x4 bias[2];
#pragma unroll
            for (int cbi = 0; cbi < 2; ++cbi) {
                const int chr = 32 * w + 8 * (l15 >> 2) + (l15 & 3) + 4 * cbi;
                a0[cbi] = *(const bf16x8*)(wp + (size_t)chr * K + 8 * l4);
                a1[cbi] = a0[cbi]; if (pq == 4) a1[cbi] = *(const bf16x8*)(wp + (size_t)chr * K + 32 + 8 * l4);
                bias[cbi] = (f32x4){0.f, 0.f, 0.f, 0.f}; if (pq < 4) bias[cbi] = *(const f32x4*)(bsrc + 32 * w + 8 * l4 + 4 * cbi);
            }
#pragma unroll
            for (int tb = 0; tb < 4; ++tb) {
                f32x4 acc[2];
#pragma unroll
                for (int cbi = 0; cbi < 2; ++cbi) {
                    acc[cbi] = bias[cbi];
                    acc[cbi] = __builtin_amdgcn_mfma_f32_16x16x32_bf16(a0[cbi], *(const LAS bf16x8*)(lowp + tb * 6400 + colb * 2), acc[cbi], 0, 0, 0);
                    if (pq == 4) acc[cbi] = __builtin_amdgcn_mfma_f32_16x16x32_bf16(a1[cbi], *(const LAS bf16x8*)(lowp + tb * 6400 + colb * 2 + 64), acc[cbi], 0, 0, 0);
                    if (pq < 4) { const float osc = pq < 2 ? 0.6065306597126334f : 1.0f;
#pragma unroll
                        for (int r = 0; r < 4; ++r) acc[cbi][r] = osc * fsigmoid(acc[cbi][r]); }
                }
                v4u o; o.x = cvtpk(acc[0][0], acc[0][1]); o.y = cvtpk(acc[0][2], acc[0][3]); o.z = cvtpk(acc[1][0], acc[1][1]); o.w = cvtpk(acc[1][2], acc[1][3]);
                *(v4u*)(dst + ((size_t)row0 + 16 * tb + l15) * 256 + 32 * w + 8 * l4) = o;
            }
        }
    }
    __syncthreads();
}

constexpr int GLA_WA_OFF = 131072 + 1024;
__device__ __forceinline__ void gla_stage_wa(Frame& F, const LayerW& W) {
    LAS bf16* wa = (LAS bf16*)(F.lds + GLA_WA_OFF); LAS float* ba = (LAS float*)(F.lds + GLA_WA_OFF + 8192);
    const float* src = W.gla_wa2 + opaque0();
    for (int q = F.tid; q < 4096; q += NTHREADS) wa[q] = (bf16)f2bf(src[q]);
    if (F.tid < 256) ba[F.tid] = (W.gla_ba + opaque0())[F.tid];
    __syncthreads();
}
__device__ __forceinline__ void gla_low_issue(Frame& F, int rowc0, v4u& w0, v4u& w1) {
    const int d = F.tid >> 8, i = (F.tid >> 2) & 63;
    const bf16* lt = ptile(F, PT_LOW) + (size_t)(rowc0 + i) * 256 + d * 16;
    w0 = *(const v4u*)lt; w1 = *(const v4u*)(lt + 8);
}
__device__ __forceinline__ void gla_decay_tables(Frame& F, const LayerW& W, int h, v4u w0, v4u w1, LAS float* CUM  ) {
    const int d = F.tid >> 8, i = (F.tid >> 2) & 63, cq = F.tid & 3;
    {
        const float al[16] = {bflo(w0.x), bfhi(w0.x), bflo(w0.y), bfhi(w0.y), bflo(w0.z), bfhi(w0.z), bflo(w0.w), bfhi(w0.w), bflo(w1.x), bfhi(w1.x), bflo(w1.y), bfhi(w1.y), bflo(w1.z), bfhi(w1.z), bflo(w1.w), bfhi(w1.w)};
        const LAS bf16* wp = (const LAS bf16*)(F.lds + GLA_WA_OFF) + d * 2048 + h * 32 + cq * 8;
        const LAS float* bp = (const LAS float*)(F.lds + GLA_WA_OFF + 8192) + d * 128 + h * 32 + cq * 8;
        f32x4 z0 = *(const LAS f32x4*)bp, z1 = *(const LAS f32x4*)(bp + 4);
#pragma unroll
        for (int r = 0; r < 16; ++r) { const v4u ww = *(const LAS v4u*)(wp + r * 128);
            z0 += (f32x4){bflo(ww.x), bfhi(ww.x), bflo(ww.y), bfhi(ww.y)} * al[r]; z1 += (f32x4){bflo(ww.z), bfhi(ww.z), bflo(ww.w), bfhi(ww.w)} * al[r]; }
        const float z[8] = {z0.x, z0.y, z0.z, z0.w, z1.x, z1.y, z1.z, z1.w};
#pragma unroll
        for (int e = 0; e < 8; ++e) { const float ls = fminf(z[e], 0.f) - __logf(1.0f + fexp(-fabsf(z[e])));
            CUM[(d * 64 + i) * 32 + cq * 8 + e] = ls * (1.0f / 16.0f); }
    }
    __syncthreads();
    {
        LAS float* TOT = CUM + 30208;
        const int seq = F.lane, d = seq >> 5, c = seq & 31, part = F.wave;
        float loc[8]; float run = 0.f;
#pragma unroll
        for (int k = 0; k < 8; ++k) { const int ip = part * 8 + k, i = d == 0 ? ip : 63 - ip; run += CUM[(d * 64 + i) * 32 + c]; loc[k] = run; }
        TOT[part * 64 + seq] = run;
        __syncthreads();
        float off = 0.f;
#pragma unroll
        for (int p = 0; p < 7; ++p) off += (p < part) ? TOT[p * 64 + seq] : 0.f;
#pragma unroll
        for (int k = 0; k < 8; ++k) { const int ip = part * 8 + k, i = d == 0 ? ip : 63 - ip; CUM[(d * 64 + i) * 32 + c] = loc[k] + off; }
    }
    __syncthreads();
}
__device__ __forceinline__ void gla_a_issue(Frame& F, int item, v4u& w0, v4u& w1, v4u& wk, v4u& wv) {
    const int bh = item / NCHUNK, c = item % NCHUNK, b = bh >> 2, h = bh & 3; const int rowc0 = chunk_row0(b, c);
    gla_low_issue(F, rowc0, w0, w1);
    const int j = (F.tid >> 2) & 63, cq = F.tid & 3;
    wk = M1_NT_LD((const v4u*)(ptile(F, PT_GLA_QK) + (size_t)(rowc0 + j) * 256 + 128 + h * 32 + cq * 8));
    const int jv = F.tid >> 3, vq = F.tid & 7;
    wv = M1_NT_LD((const v4u*)(ptile(F, PT_GLA_V) + (size_t)(rowc0 + jv) * 256 + h * 64 + vq * 8));
}
__device__ __forceinline__ void gla_a_item(Frame& F, const LayerW& W, int item, int nxt, int nitems, v4u& w0, v4u& w1, v4u& wk, v4u& wv) {
    const int bh = item / NCHUNK, c = item % NCHUNK, h = bh & 3;
    LAS float* CUM = (LAS float*)(F.lds + RING_OFF);
    LAS unsigned char* KWT = F.lds + RING_OFF + 16384;
    LAS unsigned char* VTT = KWT + 9216;
    {
        const int jv = F.tid >> 3, vq = F.tid & 7; const unsigned wvv[4] = {wv.x, wv.y, wv.z, wv.w};
#pragma unroll
        for (int e = 0; e < 8; ++e) *(LAS bf16*)(VTT + (vq * 8 + e) * 144 + jv * 2) = (bf16)((e & 1) ? (wvv[e >> 1] >> 16) : (wvv[e >> 1] & 0xffffu));
    }
    const v4u kw_ = wk, l0 = w0, l1 = w1;
    asm volatile("" ::: "memory");
    if (nxt < nitems) gla_a_issue(F, nxt, w0, w1, wk, wv);
    asm volatile("" ::: "memory");
    gla_decay_tables(F, W, h, l0, l1, CUM);
    {
        const int d = F.tid >> 8, j = (F.tid >> 2) & 63, cq = F.tid & 3;
        const float kv[8] = {bflo(kw_.x), bfhi(kw_.x), bflo(kw_.y), bfhi(kw_.y), bflo(kw_.z), bfhi(kw_.z), bflo(kw_.w), bfhi(kw_.w)};
#pragma unroll
        for (int e = 0; e < 8; ++e) { const int cc = cq * 8 + e; const float tot = d == 0 ? CUM[63 * 32 + cc] : CUM[64 * 32 + cc];
            const float val = kv[e] * fexp(tot - CUM[(d * 64 + j) * 32 + cc]); *(LAS bf16*)(KWT + (d * 32 + cc) * 144 + j * 2) = (bf16)(cvtpk(val, val) & 0xffffu); }
    }
    __syncthreads();
    {
        const int l15 = F.lane & 15, l4 = F.lane >> 4, d = F.wave >> 2, mb = F.wave & 3;
        f32x4 acc0 = (f32x4){0.f, 0.f, 0.f, 0.f}, acc1 = acc0;
#pragma unroll
        for (int ks = 0; ks < 2; ++ks) {
            const bf16x8 a = *(const LAS bf16x8*)(VTT + (16 * mb + l15) * 144 + ks * 64 + 16 * l4);
            const bf16x8 b0 = *(const LAS bf16x8*)(KWT + (d * 32 + l15) * 144 + ks * 64 + 16 * l4), b1 = *(const LAS bf16x8*)(KWT + (d * 32 + 16 + l15) * 144 + ks * 64 + 16 * l4);
            acc0 = __builtin_amdgcn_mfma_f32_16x16x32_bf16(a, b0, acc0, 0, 0, 0); acc1 = __builtin_amdgcn_mfma_f32_16x16x32_bf16(a, b1, acc1, 0, 0, 0);
        }
        float* gs = (float*)(F.ws + WS_GLAS) + ((size_t)(bh * 2 + d) * NCHUNK + c) * 2112 + 16 * mb + 4 * l4;
        *(f32x4*)(gs + l15 * 64) = acc0; *(f32x4*)(gs + (16 + l15) * 64) = acc1;
        if (F.tid < 64) { const int dd = F.tid >> 5, c2 = F.tid & 31; float* g2 = (float*)(F.ws + WS_GLAS) + ((size_t)(bh * 2 + dd) * NCHUNK + c) * 2112;
            g2[2048 + c2] = fexp(dd == 0 ? CUM[63 * 32 + c2] : CUM[64 * 32 + c2]); }
    }
    __syncthreads();
}
__device__ __forceinline__ void m1_prep(Frame& F, int l, int rep) {
    const LayerW W = layer_w(F, l);
#ifndef M1_PART
#define M1_PART 7
#endif
#ifndef M1REP_PART
#define M1REP_PART 6
#endif
    gla_stage_wa(F, W);
    if ((M1_PART & 1) && (rep == 0 || (M1REP_PART & 1))) { rope_stage(F); for (int it = F.vcu; it < NTILE64; it += F.G) attn_prep_tile(F, W, it, rep); }
    if (!RW_BASE_IN_TILE && (M1_PART & 2) && (rep == 0 || (M1REP_PART & 2)) && !((RWP_VAR & 2) && rep)) rwkv_base_stream(F, W);
    if ((M1_PART & 2) && (rep == 0 || (M1REP_PART & 2))) for (int it = F.G - 1 - F.vcu; it < NTILE64; it += F.G) rwkv_prep_tile(F, W, it, l, rep);
    if ((M1_PART & 4) && (rep == 0 || (M1REP_PART & 4))) {
        int it = (F.vcu + F.G - 32) % F.G; v4u w0, w1, wk, wv;
        if (it < 32 * NCHUNK) gla_a_issue(F, it, w0, w1, wk, wv);
        for (; it < 32 * NCHUNK; it += F.G) gla_a_item(F, W, it, it + F.G, 32 * NCHUNK, w0, w1, wk, wv);
    }
}

#define UNPK(q_) {bflo(q_.x), bfhi(q_.x), bflo(q_.y), bfhi(q_.y), bflo(q_.z), bfhi(q_.z), bflo(q_.w), bfhi(q_.w)}
__device__ __forceinline__ float fmax3(float a, float b, float c) { return __builtin_fmaxf(__builtin_fmaxf(a, b), c); }
struct AUnit { const bf16* Q; int hq0; const bf16* Kc; const bf16* Vt; const bf16* Vp; int vrow_lat, vrow_ctx; int a0, a1, b0, b1; int qpos0; float sink0, sink1; bf16* O; const float* qn; int qlat; };
#ifndef AT_RESCALE_THR
#define AT_RESCALE_THR 8.0f
#endif
constexpr int AT_KROW = 144, AT_VROW = ATT_VTR ? 192 : 144, AT_KT = 64 * AT_KROW, AT_VTB = 64 * AT_VROW, AT_BUF = AT_KT + AT_VTB;
template <bool SWA, int VAR = 0>
__device__ __forceinline__ void attn_unit(Frame& F, const AUnit& u) {
    const int lane = F.lane, r32 = lane & 31, hi = lane >> 5, wid = F.wave, hsel = wid >> 2, qrow = (wid & 3) * 32 + r32;
    const bool late = wid >= 4;
    LAS unsigned char* lds = F.lds + RING_OFF;
    constexpr int VB0 = 2 * AT_KT;
    bf16x8 qr[4];
    { const bf16* qp = u.Q + (size_t)qrow * 256 + (u.hq0 + hsel) * 64 + hi * 8;
#pragma unroll
      for (int d0 = 0; d0 < 4; ++d0) qr[d0] = *(const bf16x8*)(qp + d0 * 16); }
#if ATT_QPREP
    {
        float x[4][8];
#pragma unroll
        for (int d0 = 0; d0 < 4; ++d0) { const v4u w = __builtin_bit_cast(v4u, qr[d0]); x[d0][0] = bflo(w.x); x[d0][1] = bfhi(w.x); x[d0][2] = bflo(w.y); x[d0][3] = bfhi(w.y); x[d0][4] = bflo(w.z); x[d0][5] = bfhi(w.z); x[d0][6] = bflo(w.w); x[d0][7] = bfhi(w.w); }
        if (!SWA) {
            float ss = 0.f;
#pragma unroll
            for (int d0 = 0; d0 < 4; ++d0)
#pragma unroll
                for (int e = 0; e < 8; ++e) ss += x[d0][e] * x[d0][e];
            ss += __shfl_xor(ss, 32);
            const float rstd = __builtin_amdgcn_rsqf(ss * (1.0f / 64.0f) + NORM_EPS);
#pragma unroll
            for (int d0 = 0; d0 < 4; ++d0) { const float* gp = u.qn + d0 * 16 + hi * 8; const f32x4 g0 = *(const f32x4*)gp, g1 = *(const f32x4*)(gp + 4); const float g[8] = {g0.x, g0.y, g0.z, g0.w, g1.x, g1.y, g1.z, g1.w};
#pragma unroll
                for (int e = 0; e < 8; ++e) x[d0][e] = x[d0][e] * rstd * g[e]; }
        }
        if (u.qlat) {
            const int tq = u.qpos0 + qrow; const float* rope = (const float*)(F.ws + WS_ROPE);
#pragma unroll
            for (int hf = 0; hf < 2; ++hf) {
                const float* tp = (hf == 0 ? rope + (tq >> 6) * 32 : rope + 128 * 32 + (tq & 63) * 32) + hi * 16;
                const f32x4 c0 = *(const f32x4*)tp, c1 = *(const f32x4*)(tp + 4), c2 = *(const f32x4*)(tp + 8), c3 = *(const f32x4*)(tp + 12);
                const float cs[16] = {c0.x, c0.y, c0.z, c0.w, c1.x, c1.y, c1.z, c1.w, c2.x, c2.y, c2.z, c2.w, c3.x, c3.y, c3.z, c3.w};
#pragma unroll
                for (int e = 0; e < 8; ++e) { const float a = x[2 * hf][e], b = x[2 * hf + 1][e]; x[2 * hf][e] = a * cs[2 * e] - b * cs[2 * e + 1]; x[2 * hf + 1][e] = b * cs[2 * e] + a * cs[2 * e + 1]; }
            }
        }
#pragma unroll
        for (int d0 = 0; d0 < 4; ++d0) { const float sc_ = 0.125f * LOG2E; v4u w; w.x = cvtpk(x[d0][0] * sc_, x[d0][1] * sc_); w.y = cvtpk(x[d0][2] * sc_, x[d0][3] * sc_); w.z = cvtpk(x[d0][4] * sc_, x[d0][5] * sc_); w.w = cvtpk(x[d0][6] * sc_, x[d0][7] * sc_);
            qr[d0] = __builtin_bit_cast(bf16x8, w); }
    }
#endif
    float m = SWA ? (hsel ? u.sink1 : u.sink0) : 0.f; float lsum = (SWA && hi == 0) ? 1.0f : 0.0f;
    f32x16 o0, o1;
#pragma unroll
    for (int r = 0; r < 16; ++r) { o0[r] = 0.f; o1[r] = 0.f; }
    const int na = u.a1 - u.a0, nt = na + (u.b1 - u.b0);
    const int skey = F.tid >> 3, sch = F.tid & 7;
    const int vtr_base = (4 * hi + ((lane & 15) >> 2)) * AT_VROW + (16 * ((lane >> 4) & 1) + 4 * (lane & 3)) * 2;
    v4u kreg, vreg;
#define AT_LOAD(t) do { const int tile_ = (t) < na ? u.a0 + (t) : u.b0 + ((t) - na); kreg = *(const v4u*)(u.Kc + ((size_t)tile_ * 64 + skey) * 64 + sch * 8); \
        vreg = *(const v4u*)(u.Vt + ((size_t)tile_ * 64 + skey) * 64 + sch * 8); } while (0)
#define AT_STORE(kbuf, voff) do { *(LAS v4u*)(lds + (kbuf) * AT_KT + skey * AT_KROW + sch * 16) = kreg; \
        *(LAS v4u*)(lds + VB0 + (voff) + skey * AT_VROW + sch * 16) = vreg; } while (0)
#define AT_VREQ(voff) do { _Pragma("unroll") for (int db = 0; db < 2; ++db) _Pragma("unroll") for (int kq = 0; kq < 2; ++kq) _Pragma("unroll") for (int s2 = 0; s2 < 2; ++s2) { \
            typedef short s4v_ __attribute__((ext_vector_type(4))); \
            const LAS unsigned char* a_ = lds + VB0 + (voff) + vtr_base + (32 * kq + 16 * s2) * AT_VROW + 64 * db; \
            const s4v_ t0_ = __builtin_amdgcn_ds_read_tr16_b64_v4i16((LAS s4v_*)a_), t1_ = __builtin_amdgcn_ds_read_tr16_b64_v4i16((LAS s4v_*)(a_ + 8 * AT_VROW)); \
            const v2u u0_ = __builtin_bit_cast(v2u, t0_), u1_ = __builtin_bit_cast(v2u, t1_); vfr[db][kq][s2] = (v4u){u0_.x, u0_.y, u1_.x, u1_.y}; } } while (0)
#define AT_PVM(PF) do { _Pragma("unroll") for (int db = 0; db < 2; ++db) _Pragma("unroll") for (int kq = 0; kq < 2; ++kq) _Pragma("unroll") for (int s2 = 0; s2 < 2; ++s2) { \
            const bf16x8 vf = __builtin_bit_cast(bf16x8, vfr[db][kq][s2]); \
            if (db == 0) o0 = __builtin_amdgcn_mfma_f32_32x32x16_bf16(vf, PF[kq][s2], o0, 0, 0, 0); else o1 = __builtin_amdgcn_mfma_f32_32x32x16_bf16(vf, PF[kq][s2], o1, 0, 0, 0); } } while (0)
#define AT_QK(t, kb) do { const float nm = (!SWA && (t) == 0) ? 0.f : -m; \
        _Pragma("unroll") for (int r = 0; r < 16; ++r) { p0[r] = nm; p1[r] = nm; } \
        bf16x8 kf0[4], kf1[4]; \
        _Pragma("unroll") for (int d0 = 0; d0 < 4; ++d0) { kf0[d0] = *(const LAS bf16x8*)((kb) + r32 * AT_KROW + d0 * 32 + hi * 16); kf1[d0] = *(const LAS bf16x8*)((kb) + (32 + r32) * AT_KROW + d0 * 32 + hi * 16); } \
        __builtin_amdgcn_sched_barrier(0); \
        _Pragma("unroll") for (int d0 = 0; d0 < 4; ++d0) { p0 = __builtin_amdgcn_mfma_f32_32x32x16_bf16(kf0[d0], qr[d0], p0, 0, 0, 0); p1 = __builtin_amdgcn_mfma_f32_32x32x16_bf16(kf1[d0], qr[d0], p1, 0, 0, 0); } } while (0)
#define AT_SM(t, PF) do { const bool first = !SWA && (t) == 0; \
        if (SWA && (t) < na) { const int kbase = (u.a0 + (t)) * 64 + 4 * hi, qp = u.qpos0 + qrow; \
            _Pragma("unroll") for (int r = 0; r < 16; ++r) { const int kp = kbase + (r & 3) + 8 * (r >> 2); const int d0 = kp - qp, d1 = d0 + 32; \
                if (d0 > 128 || d0 < -128) p0[r] = -INFINITY; if (d1 > 128 || d1 < -128) p1[r] = -INFINITY; } } \
        float mx; { float a = fmax3(p0[0], p0[1], p1[0]), b = fmax3(p0[2], p0[3], p1[1]); a = fmax3(a, p1[2], p1[3]); \
          _Pragma("unroll") for (int r = 4; r < 16; r += 4) { a = fmax3(a, p0[r], p0[r + 1]); b = fmax3(b, p0[r + 2], p0[r + 3]); a = fmax3(a, p1[r], p1[r + 1]); b = fmax3(b, p1[r + 2], p1[r + 3]); } \
          mx = fmaxf(a, b); const auto rr = __builtin_amdgcn_permlane32_swap(__float_as_uint(mx), __float_as_uint(mx), false, false); mx = fmaxf(__uint_as_float(rr[0]), __uint_as_float(rr[1])); } \
        if (first || __builtin_amdgcn_ballot_w64(mx > AT_RESCALE_THR) != 0ull) { const float delta = first ? mx : fmaxf(mx, 0.f); const float alpha = first ? 0.f : fexp2(-delta); m += delta; lsum *= alpha; \
            _Pragma("unroll") for (int r = 0; r < 16; ++r) { p0[r] -= delta; p1[r] -= delta; o0[r] *= alpha; o1[r] *= alpha; } } \
        float rs = 0.f; _Pragma("unroll") for (int r = 0; r < 16; ++r) { p0[r] = fexp2(p0[r]); p1[r] = fexp2(p1[r]); rs += p0[r] + p1[r]; } lsum += rs; \
        _Pragma("unroll") for (int s = 0; s < 2; ++s) { v4u w0, w1; \
            w0.x = cvtpk(p0[8 * s + 0], p0[8 * s + 1]); w0.y = cvtpk(p0[8 * s + 2], p0[8 * s + 3]); w0.z = cvtpk(p0[8 * s + 4], p0[8 * s + 5]); w0.w = cvtpk(p0[8 * s + 6], p0[8 * s + 7]); \
            w1.x = cvtpk(p1[8 * s + 0], p1[8 * s + 1]); w1.y = cvtpk(p1[8 * s + 2], p1[8 * s + 3]); w1.z = cvtpk(p1[8 * s + 4], p1[8 * s + 5]); w1.w = cvtpk(p1[8 * s + 6], p1[8 * s + 7]); \
            PF[0][s] = __builtin_bit_cast(bf16x8, w0); PF[1][s] = __builtin_bit_cast(bf16x8, w1); } } while (0)
#define AT_TAIL(t) do { if ((t) + 1 < nt) AT_STORE(((t) + 1) & 1, vnext); \
        __syncthreads(); vprev = vcur; vcur = vnext; vnext = (vnext == 2 * AT_VTB) ? 0 : vnext + AT_VTB; } while (0)
    AT_LOAD(0); AT_STORE(0, 0); __syncthreads();
    int vprev = 0, vcur = 0, vnext = AT_VTB;
    f32x16 p0, p1; v4u vfr[2][2][2]; bf16x8 pf[2][2];
    if (!late) {
        for (int t = 0; t < nt; ++t) {
            if (t + 1 < nt) AT_LOAD(t + 1);
            AT_QK(t, lds + (t & 1) * AT_KT);
            AT_VREQ(vcur);
            __builtin_amdgcn_sched_barrier(0);
            AT_SM(t, pf);
            AT_PVM(pf);
            AT_TAIL(t);
        }
        __syncthreads();
    } else {
        for (int t = 0; t <= nt; ++t) {
            if (t + 1 < nt) AT_LOAD(t + 1);
            if (t < nt) AT_QK(t, lds + (t & 1) * AT_KT);
            if (t > 0) AT_VREQ(vprev);
            __builtin_amdgcn_sched_barrier(0);
            if (t > 0) AT_PVM(pf);
            if (t < nt) AT_SM(t, pf);
            AT_TAIL(t);
        }
    }
#undef AT_LOAD
#undef AT_STORE
#undef AT_VREQ
#undef AT_PVM
#undef AT_QK
#undef AT_SM
#undef AT_TAIL
    const float inv = 1.0f / (lsum + __shfl_xor(lsum, 32));
    bf16* op = u.O + (size_t)qrow * 1024 + (u.hq0 + hsel) * 64 + 4 * hi;
#pragma unroll
    for (int g = 0; g < 4; ++g) {
        v2u w; w.x = cvtpk(o0[4 * g] * inv, o0[4 * g + 1] * inv); w.y = cvtpk(o0[4 * g + 2] * inv, o0[4 * g + 3] * inv); *(v2u*)(op + 8 * g) = w;
        v2u x; x.x = cvtpk(o1[4 * g] * inv, o1[4 * g + 1] * inv); x.y = cvtpk(o1[4 * g + 2] * inv, o1[4 * g + 3] * inv); *(v2u*)(op + 32 + 8 * g) = x;
    }
}
constexpr int AT_VROW_T = 144, AT_VTB_T = 64 * AT_VROW_T;
template <bool SWA, int VAR = 0>
__device__ __forceinline__ void attn_unit_t(Frame& F, const AUnit& u) {
    const int lane = F.lane, r32 = lane & 31, hi = lane >> 5, wid = F.wave, hsel = wid >> 2, qrow = (wid & 3) * 32 + r32;
    const bool late = wid >= 4;
    LAS unsigned char* lds = F.lds + RING_OFF;
    constexpr int VB0 = 2 * AT_KT;
    bf16x8 qr[4];
    { const bf16* qp = u.Q + (size_t)qrow * 256 + (u.hq0 + hsel) * 64 + hi * 8;
#pragma unroll
      for (int d0 = 0; d0 < 4; ++d0) qr[d0] = *(const bf16x8*)(qp + d0 * 16); }
#if ATT_QPREP
    {
        float x[4][8];
#pragma unroll
        for (int d0 = 0; d0 < 4; ++d0) { const v4u w = __builtin_bit_cast(v4u, qr[d0]); x[d0][0] = bflo(w.x); x[d0][1] = bfhi(w.x); x[d0][2] = bflo(w.y); x[d0][3] = bfhi(w.y); x[d0][4] = bflo(w.z); x[d0][5] = bfhi(w.z); x[d0][6] = bflo(w.w); x[d0][7] = bfhi(w.w); }
        if (!SWA) {
            float ss = 0.f;
#pragma unroll
            for (int d0 = 0; d0 < 4; ++d0)
#pragma unroll
                for (int e = 0; e < 8; ++e) ss += x[d0][e] * x[d0][e];
            ss += __shfl_xor(ss, 32);
            const float rstd = __builtin_amdgcn_rsqf(ss * (1.0f / 64.0f) + NORM_EPS);
#pragma unroll
            for (int d0 = 0; d0 < 4; ++d0) { const float* gp = u.qn + d0 * 16 + hi * 8; const f32x4 g0 = *(const f32x4*)gp, g1 = *(const f32x4*)(gp + 4); const float g[8] = {g0.x, g0.y, g0.z, g0.w, g1.x, g1.y, g1.z, g1.w};
#pragma unroll
                for (int e = 0; e < 8; ++e) x[d0][e] = x[d0][e] * rstd * g[e]; }
        }
        if (u.qlat) {
            const int tq = u.qpos0 + qrow; const float* rope = (const float*)(F.ws + WS_ROPE);
#pragma unroll
            for (int hf = 0; hf < 2; ++hf) {
                const float* tp = (hf == 0 ? rope + (tq >> 6) * 32 : rope + 128 * 32 + (tq & 63) * 32) + hi * 16;
                const f32x4 c0 = *(const f32x4*)tp, c1 = *(const f32x4*)(tp + 4), c2 = *(const f32x4*)(tp + 8), c3 = *(const f32x4*)(tp + 12);
                const float cs[16] = {c0.x, c0.y, c0.z, c0.w, c1.x, c1.y, c1.z, c1.w, c2.x, c2.y, c2.z, c2.w, c3.x, c3.y, c3.z, c3.w};
#pragma unroll
                for (int e = 0; e < 8; ++e) { const float a = x[2 * hf][e], b = x[2 * hf + 1][e]; x[2 * hf][e] = a * cs[2 * e] - b * cs[2 * e + 1]; x[2 * hf + 1][e] = b * cs[2 * e] + a * cs[2 * e + 1]; }
            }
        }
#pragma unroll
        for (int d0 = 0; d0 < 4; ++d0) { const float sc_ = 0.125f * LOG2E; v4u w; w.x = cvtpk(x[d0][0] * sc_, x[d0][1] * sc_); w.y = cvtpk(x[d0][2] * sc_, x[d0][3] * sc_); w.z = cvtpk(x[d0][4] * sc_, x[d0][5] * sc_); w.w = cvtpk(x[d0][6] * sc_, x[d0][7] * sc_);
            qr[d0] = __builtin_bit_cast(bf16x8, w); }
    }
#endif
    float m = SWA ? (hsel ? u.sink1 : u.sink0) : 0.f; float lsum = (SWA && hi == 0) ? 1.0f : 0.0f;
    f32x16 o0, o1;
#pragma unroll
    for (int r = 0; r < 16; ++r) { o0[r] = 0.f; o1[r] = 0.f; }
    const int na = u.a1 - u.a0, nt = na + (u.b1 - u.b0);
    const int skey = F.tid >> 3, sch = F.tid & 7;
    v4u kreg, vreg;
#define AT_LOAD(t) do { const int tile_ = (t) < na ? u.a0 + (t) : u.b0 + ((t) - na); kreg = *(const v4u*)(u.Kc + ((size_t)tile_ * 64 + skey) * 64 + sch * 8); vreg = *(const v4u*)(u.Vt + (size_t)skey * NKEY + tile_ * 64 + sch * 8); } while (0)
#define AT_STORE(kbuf, voff) do { *(LAS v4u*)(lds + (kbuf) * AT_KT + skey * AT_KROW + sch * 16) = kreg; \
          \
        LAS unsigned char* vd_ = lds + VB0 + (voff) + skey * AT_VROW_T + (sch >> 1) * 32 + (sch & 1) * 8; \
        *(LAS v2u*)(vd_) = (v2u){vreg.x, vreg.y}; *(LAS v2u*)(vd_ + 16) = (v2u){vreg.z, vreg.w}; } while (0)
#define AT_VREQ(voff) do { _Pragma("unroll") for (int db = 0; db < 2; ++db) _Pragma("unroll") for (int kq = 0; kq < 2; ++kq) _Pragma("unroll") for (int s2 = 0; s2 < 2; ++s2) \
            vfr[db][kq][s2] = *(const LAS v4u*)(lds + VB0 + (voff) + (32 * db + r32) * AT_VROW_T + (32 * kq + 16 * s2 + 8 * hi) * 2); } while (0)
#define AT_PVM(PF) do { _Pragma("unroll") for (int db = 0; db < 2; ++db) _Pragma("unroll") for (int kq = 0; kq < 2; ++kq) _Pragma("unroll") for (int s2 = 0; s2 < 2; ++s2) { \
            const bf16x8 vf = __builtin_bit_cast(bf16x8, vfr[db][kq][s2]); \
            if (db == 0) o0 = __builtin_amdgcn_mfma_f32_32x32x16_bf16(vf, PF[kq][s2], o0, 0, 0, 0); else o1 = __builtin_amdgcn_mfma_f32_32x32x16_bf16(vf, PF[kq][s2], o1, 0, 0, 0); } } while (0)
#define AT_QK(t, kb) do { const float nm = (!SWA && (t) == 0) ? 0.f : -m; \
        _Pragma("unroll") for (int r = 0; r < 16; ++r) { p0[r] = nm; p1[r] = nm; } \
        bf16x8 kf0[4], kf1[4]; \
        _Pragma("unroll") for (int d0 = 0; d0 < 4; ++d0) { kf0[d0] = *(const LAS bf16x8*)((kb) + r32 * AT_KROW + d0 * 32 + hi * 16); kf1[d0] = *(const LAS bf16x8*)((kb) + (32 + r32) * AT_KROW + d0 * 32 + hi * 16); } \
        __builtin_amdgcn_sched_barrier(0); \
        _Pragma("unroll") for (int d0 = 0; d0 < 4; ++d0) { p0 = __builtin_amdgcn_mfma_f32_32x32x16_bf16(kf0[d0], qr[d0], p0, 0, 0, 0); p1 = __builtin_amdgcn_mfma_f32_32x32x16_bf16(kf1[d0], qr[d0], p1, 0, 0, 0); } } while (0)
#define AT_SM(t, PF) do { const bool first = !SWA && (t) == 0; \
        if (SWA && (t) < na) { const int kbase = (u.a0 + (t)) * 64 + 4 * hi, qp = u.qpos0 + qrow; \
            _Pragma("unroll") for (int r = 0; r < 16; ++r) { const int kp = kbase + (r & 3) + 8 * (r >> 2); const int d0 = kp - qp, d1 = d0 + 32; \
                if (d0 > 128 || d0 < -128) p0[r] = -INFINITY; if (d1 > 128 || d1 < -128) p1[r] = -INFINITY; } } \
        float mx; { float a = fmax3(p0[0], p0[1], p1[0]), b = fmax3(p0[2], p0[3], p1[1]); a = fmax3(a, p1[2], p1[3]); \
          _Pragma("unroll") for (int r = 4; r < 16; r += 4) { a = fmax3(a, p0[r], p0[r + 1]); b = fmax3(b, p0[r + 2], p0[r + 3]); a = fmax3(a, p1[r], p1[r + 1]); b = fmax3(b, p1[r + 2], p1[r + 3]); } \
          mx = fmaxf(a, b); const auto rr = __builtin_amdgcn_permlane32_swap(__float_as_uint(mx), __float_as_uint(mx), false, false); mx = fmaxf(__uint_as_float(rr[0]), __uint_as_float(rr[1])); } \
        if (first || __builtin_amdgcn_ballot_w64(mx > AT_RESCALE_THR) != 0ull) { const float delta = first ? mx : fmaxf(mx, 0.f); const float alpha = first ? 0.f : fexp2(-delta); m += delta; lsum *= alpha; \
            _Pragma("unroll") for (int r = 0; r < 16; ++r) { p0[r] -= delta; p1[r] -= delta; o0[r] *= alpha; o1[r] *= alpha; } } \
        float rs = 0.f; _Pragma("unroll") for (int r = 0; r < 16; ++r) { p0[r] = fexp2(p0[r]); p1[r] = fexp2(p1[r]); rs += p0[r] + p1[r]; } lsum += rs; \
        _Pragma("unroll") for (int s = 0; s < 2; ++s) { v4u w0, w1; \
            w0.x = cvtpk(p0[8 * s + 0], p0[8 * s + 1]); w0.y = cvtpk(p0[8 * s + 2], p0[8 * s + 3]); w0.z = cvtpk(p0[8 * s + 4], p0[8 * s + 5]); w0.w = cvtpk(p0[8 * s + 6], p0[8 * s + 7]); \
            w1.x = cvtpk(p1[8 * s + 0], p1[8 * s + 1]); w1.y = cvtpk(p1[8 * s + 2], p1[8 * s + 3]); w1.z = cvtpk(p1[8 * s + 4], p1[8 * s + 5]); w1.w = cvtpk(p1[8 * s + 6], p1[8 * s + 7]); \
            PF[0][s] = __builtin_bit_cast(bf16x8, w0); PF[1][s] = __builtin_bit_cast(bf16x8, w1); } } while (0)
#define AT_TAIL(t) do { if ((t) + 1 < nt) AT_STORE(((t) + 1) & 1, vnext); \
        __syncthreads(); vprev = vcur; vcur = vnext; vnext = (vnext == 2 * AT_VTB_T) ? 0 : vnext + AT_VTB_T; } while (0)
    AT_LOAD(0); AT_STORE(0, 0); __syncthreads();
    int vprev = 0, vcur = 0, vnext = AT_VTB_T;
    f32x16 p0, p1; v4u vfr[2][2][2]; bf16x8 pf[2][2];
    if (!late) {
        for (int t = 0; t < nt; ++t) {
            if (t + 1 < nt) AT_LOAD(t + 1);
            AT_QK(t, lds + (t & 1) * AT_KT);
            AT_VREQ(vcur);
            __builtin_amdgcn_sched_barrier(0);
            AT_SM(t, pf);
            AT_PVM(pf);
            AT_TAIL(t);
        }
        __syncthreads();
    } else {
        for (int t = 0; t <= nt; ++t) {
            if (t + 1 < nt) AT_LOAD(t + 1);
            if (t < nt) AT_QK(t, lds + (t & 1) * AT_KT);
            if (t > 0) AT_VREQ(vprev);
            __builtin_amdgcn_sched_barrier(0);
            if (t > 0) AT_PVM(pf);
            if (t < nt) AT_SM(t, pf);
            AT_TAIL(t);
        }
    }
#undef AT_LOAD
#undef AT_STORE
#undef AT_VREQ
#undef AT_PVM
#undef AT_QK
#undef AT_SM
#undef AT_TAIL
    const float inv = 1.0f / (lsum + __shfl_xor(lsum, 32));
    bf16* op = u.O + (size_t)qrow * 1024 + (u.hq0 + hsel) * 64 + 4 * hi;
#pragma unroll
    for (int g = 0; g < 4; ++g) {
        v2u w; w.x = cvtpk(o0[4 * g] * inv, o0[4 * g + 1] * inv); w.y = cvtpk(o0[4 * g + 2] * inv, o0[4 * g + 3] * inv); *(v2u*)(op + 8 * g) = w;
        v2u x; x.x = cvtpk(o1[4 * g] * inv, o1[4 * g + 1] * inv); x.y = cvtpk(o1[4 * g + 2] * inv, o1[4 * g + 3] * inv); *(v2u*)(op + 32 + 8 * g) = x;
    }
}
#ifndef ATT_PIPE
#define ATT_PIPE 0
#endif
template <bool SWA>
__device__ __forceinline__ void attn_unit_p(Frame& F, const AUnit& u) {
    const int lane = F.lane, r32 = lane & 31, hi = lane >> 5, wid = F.wave, hsel = wid >> 2, qrow = (wid & 3) * 32 + r32;
    LAS unsigned char* lds = F.lds + RING_OFF;
    constexpr int VB0 = 3 * AT_KT;
    bf16x8 qr[4];
    { const bf16* qp = u.Q + (size_t)qrow * 256 + (u.hq0 + hsel) * 64 + hi * 8;
#pragma unroll
      for (int d0 = 0; d0 < 4; ++d0) qr[d0] = *(const bf16x8*)(qp + d0 * 16); }
    float m = SWA ? (hsel ? u.sink1 : u.sink0) : 0.f; float lsum = (SWA && hi == 0) ? 1.0f : 0.0f;
    f32x16 o0, o1;
#pragma unroll
    for (int r = 0; r < 16; ++r) { o0[r] = 0.f; o1[r] = 0.f; }
    const int na = u.a1 - u.a0, nt = na + (u.b1 - u.b0);
    const int skey = F.tid >> 3, sch = F.tid & 7;
    v4u kreg, vreg;
#define PL_TILE(t) ((t) < na ? u.a0 + (t) : u.b0 + ((t) - na))
#define PL_LOADK(t) do { kreg = *(const v4u*)(u.Kc + ((size_t)PL_TILE(t) * 64 + skey) * 64 + sch * 8); } while (0)
#define PL_LOADV(t) do { vreg = *(const v4u*)(u.Vt + (size_t)skey * NKEY + PL_TILE(t) * 64 + sch * 8); } while (0)
#define PL_STOREK(koff) do { *(LAS v4u*)(lds + (koff) + skey * AT_KROW + sch * 16) = kreg; } while (0)
#define PL_STOREV(voff) do { LAS unsigned char* vd_ = lds + VB0 + (voff) + skey * AT_VROW + (sch >> 1) * 32 + (sch & 1) * 8; \
        *(LAS v2u*)(vd_) = (v2u){vreg.x, vreg.y}; *(LAS v2u*)(vd_ + 16) = (v2u){vreg.z, vreg.w}; } while (0)
#define PL_QK(P0, P1, koff, nm_) do { _Pragma("unroll") for (int r = 0; r < 16; ++r) { P0[r] = (nm_); P1[r] = (nm_); } \
        _Pragma("unroll") for (int d0 = 0; d0 < 4; ++d0) { \
            const bf16x8 k0_ = *(const LAS bf16x8*)(lds + (koff) + r32 * AT_KROW + d0 * 32 + hi * 16), k1_ = *(const LAS bf16x8*)(lds + (koff) + (32 + r32) * AT_KROW + d0 * 32 + hi * 16); \
            P0 = __builtin_amdgcn_mfma_f32_32x32x16_bf16(k0_, qr[d0], P0, 0, 0, 0); P1 = __builtin_amdgcn_mfma_f32_32x32x16_bf16(k1_, qr[d0], P1, 0, 0, 0); } } while (0)
#define PL_EXP4(CX, base_, W_) do { CX[base_] = fexp2(CX[base_]); CX[base_ + 1] = fexp2(CX[base_ + 1]); CX[base_ + 2] = fexp2(CX[base_ + 2]); CX[base_ + 3] = fexp2(CX[base_ + 3]); \
        rs += (CX[base_] + CX[base_ + 1]) + (CX[base_ + 2] + CX[base_ + 3]); W_[((base_) >> 1) & 3] = cvtpk(CX[base_], CX[base_ + 1]); W_[(((base_) >> 1) & 3) + 1] = cvtpk(CX[base_ + 2], CX[base_ + 3]); } while (0)
#define PL_MAX(tt_, P0, P1) do { \
        if (SWA && (tt_) < na) { const int kbase = (u.a0 + (tt_)) * 64 + 4 * hi, qp = u.qpos0 + qrow; \
            _Pragma("unroll") for (int r = 0; r < 16; ++r) { const int kp = kbase + (r & 3) + 8 * (r >> 2); const int d0 = kp - qp, d1 = d0 + 32; \
                if (d0 > 128 || d0 < -128) P0[r] = -INFINITY; if (d1 > 128 || d1 < -128) P1[r] = -INFINITY; } } \
        { float a = fmax3(P0[0], P0[1], P1[0]), b = fmax3(P0[2], P0[3], P1[1]); a = fmax3(a, P1[2], P1[3]); \
          _Pragma("unroll") for (int r = 4; r < 16; r += 4) { a = fmax3(a, P0[r], P0[r + 1]); b = fmax3(b, P0[r + 2], P0[r + 3]); a = fmax3(a, P1[r], P1[r + 1]); b = fmax3(b, P1[r + 2], P1[r + 3]); } \
          mx = fmaxf(a, b); const auto rr = __builtin_amdgcn_permlane32_swap(__float_as_uint(mx), __float_as_uint(mx), false, false); mx = fmaxf(__uint_as_float(rr[0]), __uint_as_float(rr[1])); } } while (0)
#define PL_BODY(t, C0, C1, N0, N1) do { \
        if ((t) + 2 < nt) PL_LOADK((t) + 2); if ((t) + 1 < nt) PL_LOADV((t) + 1); \
        bf16x8 kf0[4], kf1[4]; \
        _Pragma("unroll") for (int d0 = 0; d0 < 4; ++d0) { kf0[d0] = *(const LAS bf16x8*)(lds + knext + r32 * AT_KROW + d0 * 32 + hi * 16); kf1[d0] = *(const LAS bf16x8*)(lds + knext + (32 + r32) * AT_KROW + d0 * 32 + hi * 16); } \
          \
        const bool first = !SWA && (t) == 0; \
        if (first || __builtin_amdgcn_ballot_w64(mx > AT_RESCALE_THR) != 0ull) { const float delta = first ? mx : fmaxf(mx, 0.f); const float alpha = first ? 0.f : fexp2(-delta); m += delta; lsum *= alpha; \
            _Pragma("unroll") for (int r = 0; r < 16; ++r) { C0[r] -= delta; C1[r] -= delta; o0[r] *= alpha; o1[r] *= alpha; } } \
          \
        _Pragma("unroll") for (int db = 0; db < 2; ++db) _Pragma("unroll") for (int kq = 0; kq < 2; ++kq) _Pragma("unroll") for (int s2 = 0; s2 < 2; ++s2) \
            vfr[db][kq][s2] = *(const LAS v4u*)(lds + VB0 + vcur + (32 * db + r32) * AT_VROW + (32 * kq + 16 * s2 + 8 * hi) * 2); \
          \
        { const float nm = -m; float rs = 0.f; unsigned w0[8], w1[8]; \
          _Pragma("unroll") for (int r = 0; r < 16; ++r) { N0[r] = nm; N1[r] = nm; } \
          __builtin_amdgcn_sched_barrier(0); \
          _Pragma("unroll") for (int d0 = 0; d0 < 4; ++d0) { \
            N0 = __builtin_amdgcn_mfma_f32_32x32x16_bf16(kf0[d0], qr[d0], N0, 0, 0, 0); \
            { unsigned* wq_ = w0 + 4 * (d0 >> 1); PL_EXP4(C0, 4 * d0, wq_); } \
            N1 = __builtin_amdgcn_mfma_f32_32x32x16_bf16(kf1[d0], qr[d0], N1, 0, 0, 0); \
            { unsigned* wq_ = w1 + 4 * (d0 >> 1); PL_EXP4(C1, 4 * d0, wq_); } } \
          _Pragma("unroll") for (int g_ = 0; g_ < 8; ++g_) { __builtin_amdgcn_sched_group_barrier(0x008, 1, 0); __builtin_amdgcn_sched_group_barrier(0x400, 4, 0); __builtin_amdgcn_sched_group_barrier(0x002, 5, 0); } \
          lsum += rs; \
          pf[0][0] = __builtin_bit_cast(bf16x8, (v4u){w0[0], w0[1], w0[2], w0[3]}); pf[0][1] = __builtin_bit_cast(bf16x8, (v4u){w0[4], w0[5], w0[6], w0[7]}); \
          pf[1][0] = __builtin_bit_cast(bf16x8, (v4u){w1[0], w1[1], w1[2], w1[3]}); pf[1][1] = __builtin_bit_cast(bf16x8, (v4u){w1[4], w1[5], w1[6], w1[7]}); } \
        __builtin_amdgcn_sched_barrier(0); \
          \
        _Pragma("unroll") for (int kq = 0; kq < 2; ++kq) _Pragma("unroll") for (int s2 = 0; s2 < 2; ++s2) { \
            o0 = __builtin_amdgcn_mfma_f32_32x32x16_bf16(__builtin_bit_cast(bf16x8, vfr[0][kq][s2]), pf[kq][s2], o0, 0, 0, 0); \
            o1 = __builtin_amdgcn_mfma_f32_32x32x16_bf16(__builtin_bit_cast(bf16x8, vfr[1][kq][s2]), pf[kq][s2], o1, 0, 0, 0); } \
        PL_MAX((t) + 1, N0, N1); \
        _Pragma("unroll") for (int g_ = 0; g_ < 8; ++g_) { __builtin_amdgcn_sched_group_barrier(0x008, 1, 1); __builtin_amdgcn_sched_group_barrier(0x002, 3, 1); } \
          \
        if ((t) + 2 < nt) PL_STOREK(knext2); if ((t) + 1 < nt) PL_STOREV(vcur ^ AT_VTB); \
        __syncthreads(); \
        { const int k_ = kcur; kcur = knext; knext = knext2; knext2 = k_; vcur ^= AT_VTB; } } while (0)
    PL_LOADK(0); PL_LOADV(0); PL_STOREK(0); PL_STOREV(0);
    if (nt > 1) { PL_LOADK(1); PL_STOREK(AT_KT); }
    __syncthreads();
    int kcur = 0, knext = AT_KT, knext2 = 2 * AT_KT, vcur = 0;
    f32x16 pa0, pa1, pb0, pb1; v4u vfr[2][2][2]; bf16x8 pf[2][2];
    float mx;
    { const float nm0 = SWA ? -m : 0.f; PL_QK(pa0, pa1, kcur, nm0); PL_MAX(0, pa0, pa1); }
    for (int t = 0; t < nt; t += 2) {
        PL_BODY(t, pa0, pa1, pb0, pb1);
        if (t + 1 < nt) PL_BODY(t + 1, pb0, pb1, pa0, pa1);
    }
    (void)kcur;
#undef PL_TILE
#undef PL_LOADK
#undef PL_LOADV
#undef PL_STOREK
#undef PL_STOREV
#undef PL_QK
#undef PL_EXP4
#undef PL_MAX
#undef PL_BODY
    const float inv = 1.0f / (lsum + __shfl_xor(lsum, 32));
    bf16* op = u.O + (size_t)qrow * 1024 + (u.hq0 + hsel) * 64 + 4 * hi;
#pragma unroll
    for (int g = 0; g < 4; ++g) {
        v2u w; w.x = cvtpk(o0[4 * g] * inv, o0[4 * g + 1] * inv); w.y = cvtpk(o0[4 * g + 2] * inv, o0[4 * g + 3] * inv); *(v2u*)(op + 8 * g) = w;
        v2u x; x.x = cvtpk(o1[4 * g] * inv, o1[4 * g + 1] * inv); x.y = cvtpk(o1[4 * g + 2] * inv, o1[4 * g + 3] * inv); *(v2u*)(op + 32 + 8 * g) = x;
    }
}

#ifndef ATT_PROBE_VAR
#define ATT_PROBE_VAR 0
#endif
__device__ __forceinline__ void attn_item(Frame& F, const LayerW& W, int kind, int uidx, int probe = 0) {
    const bool swa = kind >= 2, ctxq = kind & 1; const int mix = swa ? 0 : 1;
    const int qb = ctxq ? (uidx & 1) : (uidx & 63), bk = ctxq ? (uidx >> 1) : (uidx >> 6), b = bk >> 1, kvh = bk & 1;
    AUnit u;
    const size_t qrow0 = ctxq ? (size_t)M_LAT + b * CTXL + qb * 128 : (size_t)b * SEQ + qb * 128;
    u.Q = ptile(F, swa ? PT_SWA_Q : PT_FA_Q) + qrow0 * 256; u.hq0 = 2 * kvh;
    u.Kc = (const bf16*)(F.ws + WS_KC) + (size_t)((b * 2 + mix) * 2 + kvh) * NKEY * 64; u.Vt = (const bf16*)(F.ws + WS_VT) + (size_t)((b * 2 + mix) * 2 + kvh) * NKEY * 64;
    u.qn = W.fa_qn; u.qlat = ctxq ? 0 : 1; u.Vp = ptile(F, mix ? PT_FA_KV : PT_SWA_KV) + 128 + kvh * 64; u.vrow_lat = b * SEQ; u.vrow_ctx = M_LAT + b * CTXL - 128 * 64;
    u.qpos0 = qb * 128; u.sink0 = W.swa_sink[2 * kvh] * LOG2E; u.sink1 = W.swa_sink[2 * kvh + 1] * LOG2E;
    u.O = (bf16*)(F.ws + WS_HO) + qrow0 * 1024 + (swa ? 256 : 512);
    if (ctxq) { u.a0 = 0; u.a1 = 0; u.b0 = 128; u.b1 = 132; }
    else if (swa) { u.a0 = max(0, 2 * qb - 2); u.a1 = min(128, 2 * qb + 4); u.b0 = 128; u.b1 = 132; }
    else { u.a0 = 0; u.a1 = 0; u.b0 = 0; u.b1 = 132; }
    if (ATT_PROBE_VAR && probe) { u.O = ptile(F, PT_RW_V) + (qrow0 & 16383) * 1024 + (swa ? 256 : 512);
        if (swa) attn_unit<true, ATT_PROBE_VAR>(F, u); else attn_unit<false, ATT_PROBE_VAR>(F, u); return; }
#if ATT_PIPE
    if (swa) attn_unit_p<true>(F, u); else attn_unit_p<false>(F, u);
#else
#if ATT_VTR
    if (swa) attn_unit<true>(F, u); else attn_unit<false>(F, u);
#else
    if (swa) attn_unit_t<true>(F, u); else attn_unit_t<false>(F, u);
#endif
#endif
}

__device__ __forceinline__ float dpp_add(float v, float w) { return v + w; }
constexpr int RW_TC = 32, RW_VSZ = RW_TC * 384;
__device__ __forceinline__ void rwkv_scan_item(Frame& F, const LayerW& W, int item) {
    const int half = item & 1, dir = (item >> 1) & 1, bh = item >> 2, b = bh >> 2, h = bh & 3;
    LAS float* VEC = (LAS float*)(F.lds + RING_OFF);
    LAS float* YB = VEC + 2 * RW_VSZ;
    bf16* yout = ptile(F, dir ? PT_RW_K : PT_RW_R);
    constexpr int NCH = NKEY / RW_TC;
#define RW_ROW(ci, st) (chunk_row0(b, scan_chunk(dir, (ci) >> 1)) + (dir ? 63 - (((ci) & 1) * 32 + (st)) : ((ci) & 1) * 32 + (st)))
    if (F.wave >= 4) {
        const bf16 *aR = rwarr(F, RA_R), *aV = rwarr(F, RA_V), *aK = rwarr(F, RA_K), *aN = rwarr(F, RA_NKK), *aA = rwarr(F, dir ? RA_AB : RA_AF), *aE = rwarr(F, dir ? RA_EB : RA_EF);
        const int t = F.tid - 256, st = t >> 3, cg = t & 7;
        float ka[8];
        { const float* kap = W.rw_ka + h * 64 + cg * 8 + opaque0();
#pragma unroll
          for (int e = 0; e < 8; ++e) ka[e] = kap[e]; }
        for (int ci = -1; ci < NCH; ++ci) {
            if (ci + 1 < NCH) {
                const size_t off = (size_t)RW_ROW(ci + 1, st) * 256 + h * 64 + cg * 8;
                const v4u gR = *(const v4u*)(aR + off), gV = *(const v4u*)(aV + off), gK = *(const v4u*)(aK + off), gN = *(const v4u*)(aN + off), gA = *(const v4u*)(aA + off), gE = *(const v4u*)(aE + off);
                const float r[8] = UNPK(gR), v[8] = UNPK(gV), k[8] = UNPK(gK), n[8] = UNPK(gN), a[8] = UNPK(gA), E[8] = UNPK(gE);
                LAS float* vp = VEC + ((ci + 1) & 1) * RW_VSZ + st * 384 + cg * 8;
                float dc[8], bb[8], kd[8];
#pragma unroll
                for (int e = 0; e < 8; ++e) { dc[e] = fexp(-E[e]); bb[e] = -n[e] * a[e]; kd[e] = k[e] * (1.0f + (a[e] - 1.0f) * ka[e]); }
                *(LAS f32x4*)(vp) = (f32x4){n[0], n[1], n[2], n[3]}; *(LAS f32x4*)(vp + 4) = (f32x4){n[4], n[5], n[6], n[7]};
                *(LAS f32x4*)(vp + 64) = (f32x4){dc[0], dc[1], dc[2], dc[3]}; *(LAS f32x4*)(vp + 68) = (f32x4){dc[4], dc[5], dc[6], dc[7]};
                *(LAS f32x4*)(vp + 128) = (f32x4){bb[0], bb[1], bb[2], bb[3]}; *(LAS f32x4*)(vp + 132) = (f32x4){bb[4], bb[5], bb[6], bb[7]};
                *(LAS f32x4*)(vp + 192) = (f32x4){kd[0], kd[1], kd[2], kd[3]}; *(LAS f32x4*)(vp + 196) = (f32x4){kd[4], kd[5], kd[6], kd[7]};
                *(LAS f32x4*)(vp + 256) = (f32x4){r[0], r[1], r[2], r[3]}; *(LAS f32x4*)(vp + 260) = (f32x4){r[4], r[5], r[6], r[7]};
                *(LAS f32x4*)(vp + 320) = (f32x4){v[0], v[1], v[2], v[3]}; *(LAS f32x4*)(vp + 324) = (f32x4){v[4], v[5], v[6], v[7]};
            }
            if (ci >= 1) {
                const LAS float* yp = YB + ((ci - 1) & 1) * (RW_TC * 32) + st * 32 + cg * 4; const f32x4 y = *(const LAS f32x4*)yp;
                v2u w; w.x = cvtpk(y.x, y.y); w.y = cvtpk(y.z, y.w);
                *(v2u*)(yout + (size_t)RW_ROW(ci - 1, st) * 256 + h * 64 + half * 32 + cg * 4) = w;
            }
            __syncthreads();
        }
        {
            const int ci = NCH; const LAS float* yp = YB + ((ci - 1) & 1) * (RW_TC * 32) + st * 32 + cg * 4; const f32x4 y = *(const LAS f32x4*)yp;
            v2u w; w.x = cvtpk(y.x, y.y); w.y = cvtpk(y.z, y.w);
            *(v2u*)(yout + (size_t)RW_ROW(ci - 1, st) * 256 + h * 64 + half * 32 + cg * 4) = w;
        }
    } else {
        typedef float f32x2 __attribute__((ext_vector_type(2)));
        const int i = F.wave * 8 + (F.lane >> 3), j = F.lane & 7;
        const float z0 = __int_as_float(opaque0());
        f32x2 S0 = (f32x2){z0, z0}, S1 = S0, S2 = S0, S3 = S0;
        __syncthreads();
#define RW_LDV(s_) do { const LAS float* vp_ = vb + (s_) * 384; n0 = *(const LAS f32x4*)(vp_); n1 = *(const LAS f32x4*)(vp_ + 4); d0 = *(const LAS f32x4*)(vp_ + 64); d1 = *(const LAS f32x4*)(vp_ + 68); \
        b0 = *(const LAS f32x4*)(vp_ + 128); b1 = *(const LAS f32x4*)(vp_ + 132); k0 = *(const LAS f32x4*)(vp_ + 192); k1 = *(const LAS f32x4*)(vp_ + 196); \
        r0 = *(const LAS f32x4*)(vp_ + 256); r1 = *(const LAS f32x4*)(vp_ + 260); vv = vvp[(s_) * 384]; } while (0)
        for (int ci = 0; ci < NCH; ++ci) {
            const LAS float* vb = VEC + (ci & 1) * RW_VSZ + 8 * j; const LAS float* vvp = VEC + (ci & 1) * RW_VSZ + 320 + half * 32 + i;
            LAS float* yb = YB + (ci & 1) * (RW_TC * 32) + i;
            f32x4 n0, n1, d0, d1, b0, b1, k0, k1, r0, r1; float vv;
            RW_LDV(0);
#pragma unroll 2
            for (int s = 0; s < RW_TC; ++s) {
                const f32x4 cn0 = n0, cn1 = n1, cd0 = d0, cd1 = d1, cb0 = b0, cb1 = b1, ck0 = k0, ck1 = k1, cr0 = r0, cr1 = r1; const float cvv = vv;
                RW_LDV(s + 1 < RW_TC ? s + 1 : s);
                f32x2 p = S0 * cn0.lo; p = __builtin_elementwise_fma(S1, cn0.hi, p); p = __builtin_elementwise_fma(S2, cn1.lo, p); p = __builtin_elementwise_fma(S3, cn1.hi, p);
                const float sa = red8_dpp(p.x + p.y);
                const f32x2 sa2 = (f32x2){sa, sa}, vv2 = (f32x2){cvv, cvv};
                S0 = __builtin_elementwise_fma(S0, cd0.lo, __builtin_elementwise_fma(ck0.lo, vv2, cb0.lo * sa2));
                S1 = __builtin_elementwise_fma(S1, cd0.hi, __builtin_elementwise_fma(ck0.hi, vv2, cb0.hi * sa2));
                S2 = __builtin_elementwise_fma(S2, cd1.lo, __builtin_elementwise_fma(ck1.lo, vv2, cb1.lo * sa2));
                S3 = __builtin_elementwise_fma(S3, cd1.hi, __builtin_elementwise_fma(ck1.hi, vv2, cb1.hi * sa2));
                f32x2 q = S0 * cr0.lo; q = __builtin_elementwise_fma(S1, cr0.hi, q); q = __builtin_elementwise_fma(S2, cr1.lo, q); q = __builtin_elementwise_fma(S3, cr1.hi, q);
                yb[s * 32] = red8_dpp(q.x + q.y);
            }
            __syncthreads();
        }
#undef RW_LDV
    }
#undef RW_ROW
    __syncthreads();
}
__device__ __forceinline__ void gla_b_item(Frame& F, int item) {
    const int dir = item & 1, bh = item >> 1;
    float* base = (float*)(F.ws + WS_GLAS) + (size_t)(bh * 2 + dir) * NCHUNK * 2112;
    const int e0 = F.tid * 4, cc = e0 >> 6;
    const float z0 = __int_as_float(opaque0());
    f32x4 S = (f32x4){z0, z0, z0, z0};
    f32x4 kvA[4], kvB[4]; float dcA[4], dcB[4];
#define GB_LOAD(KV, DC, c4_) do { _Pragma("unroll") for (int q = 0; q < 4; ++q) { const float* p_ = base + (size_t)scan_chunk(dir, (c4_) + q) * 2112; KV[q] = *(const f32x4*)(p_ + e0); DC[q] = p_[2048 + cc]; } } while (0)
#define GB_STEP(KV, DC, c4_) do { _Pragma("unroll") for (int q = 0; q < 4; ++q) { float* p_ = base + (size_t)scan_chunk(dir, (c4_) + q) * 2112; __builtin_nontemporal_store(S, (f32x4*)(p_ + e0)); S = S * DC[q] + KV[q]; } } while (0)
    GB_LOAD(kvA, dcA, 0);
#pragma unroll 1
    for (int c4 = 0; c4 < NCHUNK; c4 += 8) {
        if (c4 + 4 < NCHUNK) GB_LOAD(kvB, dcB, c4 + 4);
        GB_STEP(kvA, dcA, c4);
        if (c4 + 4 < NCHUNK) { if (c4 + 8 < NCHUNK) GB_LOAD(kvA, dcA, c4 + 8); GB_STEP(kvB, dcB, c4 + 4); }
    }
#undef GB_LOAD
#undef GB_STEP
}

namespace rwc {
constexpr int ROWB = 144, MSZ = 64 * ROWB;
typedef float f32x4_t __attribute__((ext_vector_type(4)));
__device__ __forceinline__ bf16x8 frag(const LAS unsigned char* buf, int blk, int ks, int lane) { return *(const LAS bf16x8*)(buf + (blk * 16 + (lane & 15)) * ROWB + (ks * 32 + 8 * (lane >> 4)) * 2); }
__device__ __forceinline__ void mm2(f32x4 (&acc)[2], const LAS unsigned char* A, const LAS unsigned char* Bt, int mb, int nb0, int lane) {
    const bf16x8 a0 = frag(A, mb, 0, lane), a1 = frag(A, mb, 1, lane);
#pragma unroll
    for (int j = 0; j < 2; ++j) { const bf16x8 b0 = frag(Bt, nb0 + j, 0, lane), b1 = frag(Bt, nb0 + j, 1, lane);
        acc[j] = __builtin_amdgcn_mfma_f32_16x16x32_bf16(a0, b0, acc[j], 0, 0, 0); acc[j] = __builtin_amdgcn_mfma_f32_16x16x32_bf16(a1, b1, acc[j], 0, 0, 0); }
}
__device__ __forceinline__ void st_row(LAS unsigned char* buf, const f32x4 (&acc)[2], int mb, int nb0, int lane) {
#pragma unroll
    for (int j = 0; j < 2; ++j)
#pragma unroll
        for (int r = 0; r < 4; ++r) *(LAS bf16*)(buf + (16 * mb + 4 * (lane >> 4) + r) * ROWB + (16 * (nb0 + j) + (lane & 15)) * 2) = (bf16)(cvtpk(acc[j][r], 0.f) & 0xffffu);
}
__device__ __forceinline__ void st_tr(LAS unsigned char* buf, const f32x4 (&acc)[2], int mb, int nb0, int lane) {
#pragma unroll
    for (int j = 0; j < 2; ++j) { v2u w; w.x = cvtpk(acc[j][0], acc[j][1]); w.y = cvtpk(acc[j][2], acc[j][3]);
        *(LAS v2u*)(buf + (16 * (nb0 + j) + (lane & 15)) * ROWB + (16 * mb + 4 * (lane >> 4)) * 2) = w; }
}
__device__ __forceinline__ void mmb(f32x4& acc, const LAS unsigned char* Aa, const LAS unsigned char* Ba) {
    const bf16x8 a0 = *(const LAS bf16x8*)Aa, a1 = *(const LAS bf16x8*)(Aa + 64), b0 = *(const LAS bf16x8*)Ba, b1 = *(const LAS bf16x8*)(Ba + 64);
    acc = __builtin_amdgcn_mfma_f32_16x16x32_bf16(a0, b0, acc, 0, 0, 0); acc = __builtin_amdgcn_mfma_f32_16x16x32_bf16(a1, b1, acc, 0, 0, 0);
}
__device__ __forceinline__ void mmp(f32x4 (&acc)[2], const LAS unsigned char* Aa, const LAS unsigned char* Ba) {
    const bf16x8 a0 = *(const LAS bf16x8*)Aa, a1 = *(const LAS bf16x8*)(Aa + 64);
#pragma unroll
    for (int j = 0; j < 2; ++j) { const bf16x8 b0 = *(const LAS bf16x8*)(Ba + j * 16 * ROWB), b1 = *(const LAS bf16x8*)(Ba + j * 16 * ROWB + 64);
        acc[j] = __builtin_amdgcn_mfma_f32_16x16x32_bf16(a0, b0, acc[j], 0, 0, 0); acc[j] = __builtin_amdgcn_mfma_f32_16x16x32_bf16(a1, b1, acc[j], 0, 0, 0); }
}
__device__ __forceinline__ void stb_row(LAS unsigned char* Sr, const f32x4& a) { const unsigned w0 = cvtpk(a[0], a[1]), w1 = cvtpk(a[2], a[3]);
    *(LAS bf16*)(Sr) = (bf16)(w0 & 0xffffu); *(LAS bf16*)(Sr + ROWB) = (bf16)(w0 >> 16); *(LAS bf16*)(Sr + 2 * ROWB) = (bf16)(w1 & 0xffffu); *(LAS bf16*)(Sr + 3 * ROWB) = (bf16)(w1 >> 16); }
__device__ __forceinline__ void stb_tr(LAS unsigned char* St, const f32x4& a) { v2u w; w.x = cvtpk(a[0], a[1]); w.y = cvtpk(a[2], a[3]); *(LAS v2u*)St = w; }
__device__ __forceinline__ void mm1(f32x4& acc, const LAS unsigned char* A, const LAS unsigned char* Bt, int mb, int nb, int lane) {
    acc = __builtin_amdgcn_mfma_f32_16x16x32_bf16(frag(A, mb, 0, lane), frag(Bt, nb, 0, lane), acc, 0, 0, 0); acc = __builtin_amdgcn_mfma_f32_16x16x32_bf16(frag(A, mb, 1, lane), frag(Bt, nb, 1, lane), acc, 0, 0, 0);
}
typedef short s16x4 __attribute__((ext_vector_type(4)));
__device__ __forceinline__ s16x4 op16(const f32x4& x) { v2u w; w.x = cvtpk(x[0], x[1]); w.y = cvtpk(x[2], x[3]); return __builtin_bit_cast(s16x4, w); }
__device__ __forceinline__ f32x4 mf16(s16x4 a, s16x4 b, f32x4 c) { return __builtin_amdgcn_mfma_f32_16x16x16bf16_1k(a, b, c, 0, 0, 0); }
}

__device__ __forceinline__ void rwkv_chunk_item(Frame& F, const LayerW& W, int item) {
    using namespace rwc;
    const int dir = item & 1, bh = item >> 1, b = bh >> 2, h = bh & 3;
    const int w = F.wave, mb = w >> 1, nb0 = (w & 1) * 2;
    LAS unsigned char* L = F.lds + RING_OFF;
#define SL(n) (L + (n) * MSZ)
    LAS float* TOT = (LAS float*)(F.lds + 131072 + 1024);
    LAS float* WE = TOT + 1024;
    bf16* yout = ptile(F, dir ? PT_RW_K : PT_RW_R);
    const int cp = F.tid & 31, sg = F.tid >> 5;
    float kac0, kac1; { const float* kap = W.rw_ka + opaque0() + h * 64 + 2 * cp; kac0 = kap[0]; kac1 = kap[1]; }
    const float z0 = __int_as_float(opaque0());
    f32x4 S[2]; S[0] = (f32x4){z0, z0, z0, z0}; S[1] = S[0];
#define RC_ROW(ci, s) (chunk_row0(b, scan_chunk(dir, (ci))) + (dir ? 63 - (s) : (s)))
    unsigned gr[4], gv[4], gk[4], gn[4], ga[4], ge[4];
    const unsigned char* const wsb = F.ws;
    const unsigned oR = (unsigned)(WS_Y + 0 * SZ_ROWS256), oV = (unsigned)(WS_Y + 1 * SZ_ROWS256), oK = (unsigned)(WS_Y + 2 * SZ_ROWS256), oN = (unsigned)(WS_Y + 3 * SZ_ROWS256);
    const unsigned oA = (unsigned)(WS_RW + (dir ? 1 : 0) * SZ_ROWS256), oE = (unsigned)(WS_RW + (dir ? 3 : 2) * SZ_ROWS256);
#define RC_LD(o_) (*(const unsigned*)(wsb + (size_t)((o_) + bo_)))
#define RC_LOAD(ci) do { _Pragma("unroll") for (int s4 = 0; s4 < 4; ++s4) { const unsigned bo_ = (unsigned)RC_ROW(ci, 4 * sg + s4) * 512u + (unsigned)((h * 64 + 2 * cp) * 2); \
        gr[s4] = RC_LD(oR); gv[s4] = RC_LD(oV); gk[s4] = RC_LD(oK); gn[s4] = RC_LD(oN); ga[s4] = RC_LD(oA); ge[s4] = RC_LD(oE); } } while (0)
    const int l15 = F.lane & 15, l4 = F.lane >> 4;
    const int jd = mb - nb0; const bool diag = (jd == 0 || jd == 1);
    unsigned mstrict = 0u, mincl = 0u;
#pragma unroll
    for (int r = 0; r < 4; ++r) { mstrict |= (4 * l4 + r < l15 ? 1u : 0u) << r; mincl |= (4 * l4 + r <= l15 ? 1u : 0u) << r; }
    const LAS unsigned char* pa_lo = L + (16 * mb + l15) * ROWB + 16 * l4; const LAS unsigned char* pa_hi = pa_lo + 7 * MSZ;
    const LAS unsigned char* pb_lo = L + (16 * nb0 + l15) * ROWB + 16 * l4; const LAS unsigned char* pb_hi = pb_lo + 7 * MSZ;
    LAS unsigned char* pr_lo = L + (16 * mb + 4 * l4) * ROWB + (16 * nb0 + l15) * 2; LAS unsigned char* pr_hi = pr_lo + 7 * MSZ;
    LAS unsigned char* pt_lo = L + (16 * nb0 + l15) * ROWB + (16 * mb + 4 * l4) * 2; LAS unsigned char* pt_hi = pt_lo + 7 * MSZ;
    asm volatile("" : "+v"(pa_hi), "+v"(pb_hi), "+v"(pr_hi), "+v"(pt_hi));
#define PA(n) ((n) < 7 ? pa_lo + (n) * MSZ : pa_hi + ((n) - 7) * MSZ)
#define PB(n) ((n) < 7 ? pb_lo + (n) * MSZ : pb_hi + ((n) - 7) * MSZ)
#define PR(n) ((n) < 7 ? pr_lo + (n) * MSZ : pr_hi + ((n) - 7) * MSZ)
#define PT(n) ((n) < 7 ? pt_lo + (n) * MSZ : pt_hi + ((n) - 7) * MSZ)
    RC_LOAD(0);
    v2u ypend[2];
#define RC_YSTORE(cprev) do { _Pragma("unroll") for (int j = 0; j < 2; ++j) { const int col_ = 16 * (nb0 + j) + (F.lane & 15); \
        *(v2u*)(yout + ((unsigned)RC_ROW(cprev, col_) * 256u + (unsigned)(h * 64 + 16 * mb + 4 * (F.lane >> 4)))) = ypend[j]; } } while (0)
    for (int ci = 0; ci < NCHUNK; ++ci) {
        {
            float e0[4], e1[4], cl0[4], cl1[4], c0 = 0.f, c1 = 0.f;
#pragma unroll
            for (int s4 = 0; s4 < 4; ++s4) { e0[s4] = bflo(ge[s4]); e1[s4] = bfhi(ge[s4]); c0 += e0[s4]; c1 += e1[s4]; cl0[s4] = c0; cl1[s4] = c1; }
            *(LAS f32x2_t*)(TOT + sg * 64 + 2 * cp) = (f32x2_t){c0, c1};
            __syncthreads();
            float off0 = 0.f, off1 = 0.f, tot0 = 0.f, tot1 = 0.f;
#pragma unroll
            for (int p = 0; p < 16; ++p) { const f32x2_t tp = *(const LAS f32x2_t*)(TOT + p * 64 + 2 * cp); tot0 += tp.x; tot1 += tp.y; off0 += (p < sg) ? tp.x : 0.f; off1 += (p < sg) ? tp.y : 0.f; }
            const float wend0 = fexp(-tot0), wend1 = fexp(-tot1);
            if (sg == 0) *(LAS f32x2_t*)(WE + 2 * cp) = (f32x2_t){wend0, wend1};
            float pprev0 = 0.f, pprev1 = 0.f;
            unsigned tA0[2], tA1[2], tV0[2], tV1[2], tB0[2], tB1[2], tK0[2], tK1[2];
#pragma unroll
            for (int s4 = 0; s4 < 4; ++s4) {
                const int s = 4 * sg + s4;
                const float cum0 = off0 + cl0[s4], cum1 = off1 + cl1[s4];
                const float p0 = fexp(-cum0), p1 = fexp(-cum1), pm0 = s4 == 0 ? fexp(-off0) : pprev0, pm1 = s4 == 0 ? fexp(-off1) : pprev1, q0 = frcp(p0), q1 = frcp(p1);
                pprev0 = p0; pprev1 = p1;
                const float n0 = bflo(gn[s4]), n1 = bfhi(gn[s4]), al0 = bflo(ga[s4]), al1 = bfhi(ga[s4]);
                const float bb0 = -n0 * al0, bb1 = -n1 * al1, kd0 = bflo(gk[s4]) * (1.0f + (al0 - 1.0f) * kac0), kd1 = bfhi(gk[s4]) * (1.0f + (al1 - 1.0f) * kac1);
                const unsigned wA = cvtpk(n0 * pm0, n1 * pm1), wR = cvtpk(bflo(gr[s4]) * p0, bfhi(gr[s4]) * p1), wB = cvtpk(bb0 * q0, bb1 * q1), wK = cvtpk(kd0 * q0, kd1 * q1);
                const unsigned wBe = cvtpk(bb0 * q0 * wend0, bb1 * q1 * wend1), wKe = cvtpk(kd0 * q0 * wend0, kd1 * q1 * wend1), wV = gv[s4];
                *(LAS unsigned*)(SL(0) + s * ROWB + 4 * cp) = wA; *(LAS unsigned*)(SL(1) + s * ROWB + 4 * cp) = wR; *(LAS unsigned*)(SL(2) + s * ROWB + 4 * cp) = wB; *(LAS unsigned*)(SL(3) + s * ROWB + 4 * cp) = wK;
                if (s4 & 1) { tA0[s4 >> 1] |= wA << 16; tA1[s4 >> 1] |= wA & 0xffff0000u; tV0[s4 >> 1] |= wV << 16; tV1[s4 >> 1] |= wV & 0xffff0000u;
                              tB0[s4 >> 1] |= wBe << 16; tB1[s4 >> 1] |= wBe & 0xffff0000u; tK0[s4 >> 1] |= wKe << 16; tK1[s4 >> 1] |= wKe & 0xffff0000u; }
                else { tA0[s4 >> 1] = wA & 0xffffu; tA1[s4 >> 1] = wA >> 16; tV0[s4 >> 1] = wV & 0xffffu; tV1[s4 >> 1] = wV >> 16;
                       tB0[s4 >> 1] = wBe & 0xffffu; tB1[s4 >> 1] = wBe >> 16; tK0[s4 >> 1] = wKe & 0xffffu; tK1[s4 >> 1] = wKe >> 16; }
            }
            const int r0 = (2 * cp) * ROWB + sg * 8, r1 = r0 + ROWB;
            *(LAS v2u*)(SL(4) + r0) = (v2u){tA0[0], tA0[1]}; *(LAS v2u*)(SL(4) + r1) = (v2u){tA1[0], tA1[1]}; *(LAS v2u*)(SL(5) + r0) = (v2u){tV0[0], tV0[1]}; *(LAS v2u*)(SL(5) + r1) = (v2u){tV1[0], tV1[1]};
            *(LAS v2u*)(SL(6) + r0) = (v2u){tB0[0], tB0[1]}; *(LAS v2u*)(SL(6) + r1) = (v2u){tB1[0], tB1[1]}; *(LAS v2u*)(SL(7) + r0) = (v2u){tK0[0], tK0[1]}; *(LAS v2u*)(SL(7) + r1) = (v2u){tK1[0], tK1[1]};
        }
        __syncthreads();
        if (ci > 0) RC_YSTORE(ci - 1);
        if (ci + 1 < NCHUNK) RC_LOAD(ci + 1);
        const f32x4 Z4 = (f32x4){z0, z0, z0, z0};
        f32x4 Tc[2], t0[2], t1[2], t2[2], t3[2];
        t0[0] = Z4; t0[1] = Z4; t1[0] = Z4; t1[1] = Z4; t2[0] = Z4; t2[1] = Z4; t3[0] = Z4; t3[1] = Z4;
#pragma unroll
        for (int j = 0; j < 2; ++j) if (nb0 + j >= mb) {
            mmb(t0[j], PA(2), PB(0) + j * 16 * ROWB); mmb(t1[j], PA(3), PB(0) + j * 16 * ROWB); mmb(t2[j], PA(2), PB(1) + j * 16 * ROWB); mmb(t3[j], PA(3), PB(1) + j * 16 * ROWB);
            if (nb0 + j == mb) {
#pragma unroll
                for (int r = 0; r < 4; ++r) { const bool st = (mstrict >> r) & 1, in = (mincl >> r) & 1; t0[j][r] = st ? t0[j][r] : 0.f; t1[j][r] = st ? t1[j][r] : 0.f; t2[j][r] = in ? t2[j][r] : 0.f; t3[j][r] = in ? t3[j][r] : 0.f; } } }
        f32x4 Mt = Z4;
        if (diag) mmb(Mt, PA(0), PA(2));
#pragma unroll
        for (int j = 0; j < 2; ++j) { stb_tr(PT(9) + j * 16 * ROWB, t0[j]); stb_tr(PT(10) + j * 16 * ROWB, t1[j]); stb_tr(PT(11) + j * 16 * ROWB, t2[j]); stb_tr(PT(12) + j * 16 * ROWB, t3[j]); }
        __syncthreads();
        f32x4 z2[2]; z2[0] = Z4; z2[1] = Z4;
        mmp(z2, PA(5), PB(10));
        Tc[0] = Z4; Tc[1] = Z4;
        if (diag) {
            const f32x4 M = jd == 0 ? t0[0] : t0[1];
            f32x4 T, Tt;
#pragma unroll
            for (int r = 0; r < 4; ++r) { const int ro = 4 * l4 + r;
                Mt[r] = ro > l15 ? Mt[r] : 0.f;
                T[r] = (ro == l15 ? 1.0f : 0.f) + ((ro + 1 == l15 && (ro & 1) == 0) ? M[r] : 0.f);
                Tt[r] = (ro == l15 ? 1.0f : 0.f) + ((l15 + 1 == ro && (l15 & 1) == 0) ? Mt[r] : 0.f); }
            const s16x4 oM = op16(M), oMt = op16(Mt);
#pragma unroll
            for (int n = 2; n <= 8; n *= 2) {
                const s16x4 oT = op16(T), oTt = op16(Tt);
                f32x4 Wm = mf16(oTt, oM, Z4);
                f32x4 Wt = mf16(oM, oTt, Z4);
#pragma unroll
                for (int r = 0; r < 4; ++r) { const int ro = 4 * l4 + r;
                    const bool okW = (ro / (2 * n) == l15 / (2 * n)) && (ro / n != l15 / n) && ro < l15;
                    const bool okT = (l15 / (2 * n) == ro / (2 * n)) && (l15 / n != ro / n) && l15 < ro;
                    Wm[r] = okW ? Wm[r] : 0.f; Wt[r] = okT ? Wt[r] : 0.f; }
                const s16x4 oW = op16(Wm), oWt = op16(Wt); (void)oW;
                T = mf16(oWt, oT, T);
                Tt = mf16(oT, oWt, Tt);
            }
            if (jd == 0) Tc[0] = T; else Tc[1] = T;
        }
#pragma unroll
        for (int j = 0; j < 2; ++j) { stb_row(PR(13) + j * 32, Tc[j]); stb_tr(PT(8) + j * 16 * ROWB, Tc[j]); }
        __syncthreads();
#define TLEVEL(COND, Trow, Ttr, TrowN, TtrN, EXTRA_B, LAST) do { \
        t0[0] = Z4; t0[1] = Z4; \
        _Pragma("unroll") for (int j = 0; j < 2; ++j) { const int nb = nb0 + j; if (COND) mmb(t0[j], PA(Trow), PB(9) + j * 16 * ROWB); stb_row(PR(0) + j * 32, t0[j]); } \
        __syncthreads(); \
        _Pragma("unroll") for (int j = 0; j < 2; ++j) { const int nb = nb0 + j; if (COND) mmb(Tc[j], PA(0), PB(Ttr) + j * 16 * ROWB); } \
        EXTRA_B; \
        _Pragma("unroll") for (int j = 0; j < 2; ++j) { if (!(LAST)) stb_row(PR(TrowN) + j * 32, Tc[j]); stb_tr(PT(TtrN) + j * 16 * ROWB, Tc[j]); } \
        __syncthreads(); } while (0)
        TLEVEL(((mb >> 1) == (nb >> 1) && mb < nb), 13, 8, 2, 3, { stb_row(PR(10), z2[0]); stb_row(PR(10) + 32, z2[1]); }, false);
        TLEVEL((mb < 2 && nb >= 2), 2, 3, 13, 8, (void)0, true);
#undef TLEVEL
        t0[0] = Z4; t0[1] = Z4; t1[0] = Z4; t1[1] = Z4;
        mmp(t0, PA(4), PB(8)); mmp(t1, PA(10), PB(8));
#pragma unroll
        for (int j = 0; j < 2; ++j) { stb_row(PR(0) + j * 32, t0[j]); stb_row(PR(3) + j * 32, t1[j]); }
        __syncthreads();
        f32x4 aS[2], aY[2]; aS[0] = Z4; aS[1] = Z4; aY[0] = Z4; aY[1] = Z4; t0[0] = Z4; t0[1] = Z4; t1[0] = Z4; t1[1] = Z4;
        mmp(t0, PA(0), PB(6)); mmp(t1, PA(0), PB(11));
#pragma unroll
        for (int j = 0; j < 2; ++j) { const v2u rw = *(const LAS v2u*)(PT(1) + j * 16 * ROWB);
            t1[j][0] += bflo(rw.x); t1[j][1] += bfhi(rw.x); t1[j][2] += bflo(rw.y); t1[j][3] += bfhi(rw.y); }
        mmp(aS, PA(3), PB(6)); mmp(aS, PA(5), PB(7)); mmp(aY, PA(3), PB(11)); mmp(aY, PA(5), PB(12));
#pragma unroll
        for (int j = 0; j < 2; ++j) { stb_tr(PT(9) + j * 16 * ROWB, t0[j]); stb_tr(PT(13) + j * 16 * ROWB, t1[j]); stb_row(PR(2) + j * 32, S[j]); }
        __syncthreads();
        mmp(aY, PA(2), PB(13)); mmp(aS, PA(2), PB(9));
#pragma unroll
        for (int j = 0; j < 2; ++j) { const float we = WE[16 * (nb0 + j) + l15];
            S[j] = S[j] * we + aS[j];
            ypend[j].x = cvtpk(aY[j][0], aY[j][1]); ypend[j].y = cvtpk(aY[j][2], aY[j][3]); }
        __syncthreads();
    }
    RC_YSTORE(NCHUNK - 1);
#undef RC_YSTORE
#undef PA
#undef PB
#undef PR
#undef PT
#undef SL
#undef RC_ROW
#undef RC_LOAD
#undef RC_LD
}
__device__ __forceinline__ void m2_queue(Frame& F, int l, int rep) {
    const LayerW W = layer_w(F, l);
    const bool need_ctx = l < NLAYER - 1;
    #ifndef RW_CHUNKED
#define RW_CHUNKED 1
#endif
    const int n0 = RW_CHUNKED ? 64 : 128, nA = n0 + 1024, nB = nA + (need_ctx ? 32 : 0), nC = nB + 64, nD = nC + 1024, nE = nD + (need_ctx ? 32 : 0);
    for (;;) {
        { int t_; asm volatile("v_mov_b32 %0, %1" : "=v"(t_) : "v"(threadIdx.x)); F.tid = t_; F.lane = t_ & 63; F.wave = __builtin_amdgcn_readfirstlane(t_ >> 6); }
        if (F.tid == 0) F.MISC[16] = __hip_atomic_fetch_add(F.ctl + CW_QUEUE + 64 * l + 128 * rep, 1u, RLX_AGENT);
        __syncthreads();
        const int it = (int)F.MISC[16];
        __syncthreads();
        if (it >= nE) break;
#ifdef MK_M2REP_KIND
        if (rep && (MK_M2REP_KIND == 1 ? it >= n0 : (it < n0 || (it >= nB && it < nC)))) continue;
#endif
        if (it < n0) { if (RW_CHUNKED) rwkv_chunk_item(F, W, it); else rwkv_scan_item(F, W, it); }
        else if (it < nA) attn_item(F, W, 0, it - n0, rep);
        else if (it < nB) attn_item(F, W, 1, it - nA, rep);
        else if (it < nC) { if (rep == 0) gla_b_item(F, it - nB); }
        else if (it < nD) attn_item(F, W, 2, it - nC, rep);
        else attn_item(F, W, 3, it - nD, rep);
    }
}

#ifndef GC_NT
#define GC_NT 0
#endif
#if GC_NT
#define GC_LD(p_) __builtin_nontemporal_load(p_)
#else
#define GC_LD(p_) (*(p_))
#endif
__device__ __forceinline__ void gla_c_issue(Frame& F, int item, v4u& w0, v4u& w1, v4u& wq, v4u& wk, v4u& wv, f32x4& s0, f32x4& s1, v2u& g0, v2u& g1) {
    const int bh = item / NCHUNK, c = item % NCHUNK, b = bh >> 2, h = bh & 3; const int rowc0 = chunk_row0(b, c);
    gla_low_issue(F, rowc0, w0, w1);
    const int i = (F.tid >> 2) & 63, cq = F.tid & 3;
    const bf16* qp = ptile(F, PT_GLA_QK) + (size_t)(rowc0 + i) * 256 + h * 32 + cq * 8; wq = GC_LD((const v4u*)qp); wk = GC_LD((const v4u*)(qp + 128));
    const int jv = F.tid >> 3, vq = F.tid & 7;
    wv = GC_LD((const v4u*)(ptile(F, PT_GLA_V) + (size_t)(rowc0 + jv) * 256 + h * 64 + vq * 8));
    const int e0 = F.tid * 8, dd = e0 >> 11, off = e0 & 2047;
    const float* gs = (const float*)(F.ws + WS_GLAS) + ((size_t)(bh * 2 + dd) * NCHUNK + c) * 2112 + off;
    s0 = __builtin_nontemporal_load((const f32x4*)gs); s1 = __builtin_nontemporal_load((const f32x4*)(gs + 4));
    const int l15 = F.lane & 15, l4 = F.lane >> 4, w = F.wave, ib = w & 3, vb0 = (w >> 2) * 2;
    const bf16* gp = ptile(F, PT_GLA_G) + ((size_t)rowc0 + 16 * ib + l15) * 256 + h * 64 + 16 * vb0 + 4 * l4;
    g0 = __builtin_nontemporal_load((const v2u*)gp); g1 = __builtin_nontemporal_load((const v2u*)(gp + 16));
}
__device__ __forceinline__ void gla_c_item(Frame& F, const LayerW& W, int item, int nxt, int nitems, v4u& w0, v4u& w1, v4u& wq_, v4u& wk_, v4u& wv_, f32x4& s0_, f32x4& s1_, v2u& g0_, v2u& g1_, f32x4 on0, f32x4 on1) {
    using namespace rwc;
    const int bh = item / NCHUNK, c = item % NCHUNK, b = bh >> 2, h = bh & 3; const int rowc0 = chunk_row0(b, c);
    LAS float* CUM = (LAS float*)(F.lds + RING_OFF);
    LAS unsigned char* SB = F.lds + RING_OFF + 16384;
    LAS float* SSQ = (LAS float*)(SB + 8 * MSZ);
#define GS(n) (SB + (n) * MSZ)
    {
        const int jv = F.tid >> 3, vq = F.tid & 7;
        const unsigned wvv[4] = {wv_.x, wv_.y, wv_.z, wv_.w};
#pragma unroll
        for (int e = 0; e < 8; ++e) *(LAS bf16*)(GS(5) + (vq * 8 + e) * ROWB + jv * 2) = (bf16)((e & 1) ? (wvv[e >> 1] >> 16) : (wvv[e >> 1] & 0xffffu));
        const int e0 = F.tid * 8, dd = e0 >> 11, off = e0 & 2047, cc2 = off >> 6, v0 = off & 63;
        const float sv[8] = {s0_.x, s0_.y, s0_.z, s0_.w, s1_.x, s1_.y, s1_.z, s1_.w};
#pragma unroll
        for (int e = 0; e < 8; ++e) *(LAS bf16*)(GS(6) + (v0 + e) * ROWB + (dd * 32 + cc2) * 2) = (bf16)(cvtpk(sv[e], sv[e]) & 0xffffu);
    }
    const v4u l0 = w0, l1 = w1, wq = wq_, wk = wk_; const v2u gg0 = g0_, gg1 = g1_;
    asm volatile("" ::: "memory");
    if (nxt < nitems) gla_c_issue(F, nxt, w0, w1, wq_, wk_, wv_, s0_, s1_, g0_, g1_);
    asm volatile("" ::: "memory");
    gla_decay_tables(F, W, h, l0, l1, CUM);
    {
        const int d = F.tid >> 8, i = (F.tid >> 2) & 63, cq = F.tid & 3;
        const float q[8] = {bflo(wq.x), bfhi(wq.x), bflo(wq.y), bfhi(wq.y), bflo(wq.z), bfhi(wq.z), bflo(wq.w), bfhi(wq.w)};
        const float k[8] = {bflo(wk.x), bfhi(wk.x), bflo(wk.y), bfhi(wk.y), bflo(wk.z), bfhi(wk.z), bflo(wk.w), bfhi(wk.w)};
        float qx[8], kx[8], qe[8];
#pragma unroll
        for (int e = 0; e < 8; ++e) { const int cc = cq * 8 + e; const float cm = CUM[(d * 64 + i) * 32 + cc], rf = d == 0 ? CUM[31 * 32 + cc] : CUM[(64 + 32) * 32 + cc];
            const float qs = q[e] * 0.17677669529663687f; qx[e] = qs * fexp(cm - rf); kx[e] = k[e] * fexp(rf - cm); qe[e] = qs * fexp(cm); }
        *(LAS v4u*)(GS(d) + i * ROWB + cq * 16) = (v4u){cvtpk(qx[0], qx[1]), cvtpk(qx[2], qx[3]), cvtpk(qx[4], qx[5]), cvtpk(qx[6], qx[7])};
        *(LAS v4u*)(GS(2 + d) + i * ROWB + cq * 16) = (v4u){cvtpk(kx[0], kx[1]), cvtpk(kx[2], kx[3]), cvtpk(kx[4], kx[5]), cvtpk(kx[6], kx[7])};
        *(LAS v4u*)(GS(4) + i * ROWB + d * 64 + cq * 16) = (v4u){cvtpk(qe[0], qe[1]), cvtpk(qe[2], qe[3]), cvtpk(qe[4], qe[5]), cvtpk(qe[6], qe[7])};
    }
    __syncthreads();
    const int l15 = F.lane & 15, l4 = F.lane >> 4, w = F.wave;
    {
        const int jb = w >> 1, ib0 = (w & 1) * 2;
#pragma unroll
        for (int jj = 0; jj < 2; ++jj) { const int ib = ib0 + jj; f32x4 acc = (f32x4){0.f, 0.f, 0.f, 0.f};
            if (jb <= ib) { f32x4 a = (f32x4){0.f, 0.f, 0.f, 0.f};
                a = __builtin_amdgcn_mfma_f32_16x16x32_bf16(*(const LAS bf16x8*)(GS(2) + (16 * jb + l15) * ROWB + 16 * l4), *(const LAS bf16x8*)(GS(0) + (16 * ib + l15) * ROWB + 16 * l4), a, 0, 0, 0);
                if (jb == ib) {
#pragma unroll
                    for (int r = 0; r < 4; ++r) a[r] = (4 * l4 + r <= l15) ? a[r] : 0.f; }
                acc += a; }
            if (jb >= ib) { f32x4 a = (f32x4){0.f, 0.f, 0.f, 0.f};
                a = __builtin_amdgcn_mfma_f32_16x16x32_bf16(*(const LAS bf16x8*)(GS(3) + (16 * jb + l15) * ROWB + 16 * l4), *(const LAS bf16x8*)(GS(1) + (16 * ib + l15) * ROWB + 16 * l4), a, 0, 0, 0);
                if (jb == ib) {
#pragma unroll
                    for (int r = 0; r < 4; ++r) a[r] = (4 * l4 + r >= l15) ? a[r] : 0.f; }
                acc += a; }
            stb_tr(GS(7) + (16 * ib + l15) * ROWB + (16 * jb + 4 * l4) * 2, acc); }
    }
    __syncthreads();
    {
        const int ib = w & 3, vb0 = (w >> 2) * 2;
        f32x4 o[2]; o[0] = (f32x4){0.f, 0.f, 0.f, 0.f}; o[1] = o[0];
#pragma unroll
        for (int vv = 0; vv < 2; ++vv) { const int vb = vb0 + vv;
            mmb(o[vv], GS(5) + (16 * vb + l15) * ROWB + 16 * l4, GS(7) + (16 * ib + l15) * ROWB + 16 * l4);
            mmb(o[vv], GS(6) + (16 * vb + l15) * ROWB + 16 * l4, GS(4) + (16 * ib + l15) * ROWB + 16 * l4); }
        float ss = 0.f;
#pragma unroll
        for (int vv = 0; vv < 2; ++vv)
#pragma unroll
            for (int r = 0; r < 4; ++r) ss += o[vv][r] * o[vv][r];
        ss += __shfl_xor(ss, 16); ss += __shfl_xor(ss, 32);
        if (l4 == 0) SSQ[w * 16 + l15] = ss;
        __syncthreads();
        const float rstd = 1.0f / sqrtf((SSQ[w * 16 + l15] + SSQ[(w ^ 4) * 16 + l15]) * (1.0f / 64.0f) + NORM_EPS);
        const size_t row = (size_t)rowc0 + 16 * ib + l15;
#pragma unroll
        for (int vv = 0; vv < 2; ++vv) { const int v0 = 16 * (vb0 + vv) + 4 * l4;
            const v2u wg = vv ? gg1 : gg0; const f32x4 on = vv ? on1 : on0;
            const float g[4] = {bflo(wg.x), bfhi(wg.x), bflo(wg.y), bfhi(wg.y)};
            float rr[4];
#pragma unroll
            for (int r = 0; r < 4; ++r) rr[r] = o[vv][r] * rstd * on[r] * (g[r] * fsigmoid(g[r]));
            v2u wo; wo.x = cvtpk(rr[0], rr[1]); wo.y = cvtpk(rr[2], rr[3]);
            *(v2u*)((bf16*)(F.ws + WS_HO) + row * 1024 + h * 64 + v0) = wo; }
    }
    __syncthreads();
#undef GS
}
__device__ __forceinline__ void rwkv_finish(Frame& F, const LayerW& W, int nrows) {
    const int gw = F.vcu * NWAVES + F.wave, NGW = F.G * NWAVES;
    const bf16 *yf = ptile(F, PT_RW_R), *yb = ptile(F, PT_RW_K);
    const bf16 *aR = rwarr(F, RA_R), *aV = rwarr(F, RA_V), *aK = rwarr(F, RA_K), *aAF = rwarr(F, RA_AF), *aAB = rwarr(F, RA_AB), *aG = rwarr(F, RA_G);
    bf16* O = (bf16*)(F.ws + WS_HO);
    const int sub = F.lane >> 5, c0 = (F.lane & 31) * 8;
    float lw[8], lb[8], ka[8], rk[8];
    { const int oz = opaque0(); const float *p0 = W.rw_lnw + c0 + oz, *p1 = W.rw_lnb + c0 + oz, *p2 = W.rw_ka + c0 + oz, *p3 = W.rw_rk + c0 + oz;
#pragma unroll
      for (int e = 0; e < 8; ++e) { lw[e] = p0[e]; lb[e] = p1[e]; ka[e] = p2[e]; rk[e] = p3[e]; } }
    const int npair = nrows >> 1;
#pragma unroll 4
    for (int it = gw; it < npair; it += NGW) {
        const size_t off = (size_t)(2 * it + sub) * 256 + c0;
#define RF_LD(p_) __builtin_nontemporal_load((const v4u*)(p_))
        const v4u wyf = RF_LD(yf + off), wyb = RF_LD(yb + off), wr = RF_LD(aR + off), wv = RF_LD(aV + off), wk = RF_LD(aK + off),
                  waf = RF_LD(aAF + off), wab = RF_LD(aAB + off), wg = RF_LD(aG + off);
#undef RF_LD
        const float y1[8] = UNPK(wyf), y2[8] = UNPK(wyb), r[8] = UNPK(wr), v[8] = UNPK(wv), k[8] = UNPK(wk), af[8] = UNPK(waf), ab[8] = UNPK(wab), g[8] = UNPK(wg);
        float y[8], s = 0.f, dot = 0.f;
#pragma unroll
        for (int e = 0; e < 8; ++e) { y[e] = y1[e] + y2[e]; s += y[e]; dot += r[e] * (k[e] * (2.0f + (af[e] + ab[e] - 2.0f) * ka[e])) * rk[e]; }
        const float mean = red8_dpp(s) * (1.0f / 64.0f); dot = red8_dpp(dot);
        float q = 0.f;
#pragma unroll
        for (int e = 0; e < 8; ++e) { y[e] -= mean; q += y[e] * y[e]; }
        const float rstd = __builtin_amdgcn_rsqf(red8_dpp(q) * (1.0f / 64.0f) + 64e-5f);
        float o[8];
#pragma unroll
        for (int e = 0; e < 8; ++e) o[e] = (y[e] * rstd * lw[e] + lb[e] + dot * v[e]) * g[e];
        v4u w; w.x = cvtpk(o[0], o[1]); w.y = cvtpk(o[2], o[3]); w.z = cvtpk(o[4], o[5]); w.w = cvtpk(o[6], o[7]);
        *(v4u*)(O + (size_t)(2 * it + sub) * 1024 + 768 + c0) = w;
    }
}
#ifndef M3_SWAP
#define M3_SWAP 0
#endif
__device__ __forceinline__ void m3_finish(Frame& F, int l) {
    const LayerW W = layer_w(F, l);
    const bool need_ctx = l < NLAYER - 1;
    gla_stage_wa(F, W);
    if (M3_SWAP && (F.vcu & 1)) rwkv_finish(F, W, need_ctx ? M_ALL : M_LAT);
    {
        const int N = 32 * NCHUNK;
        auto valid_from = [&](int it) { while (it < N && !need_ctx && (it % NCHUNK) < 4) it += F.G; return it; };
        const int l4 = F.lane >> 4, vb0 = (F.wave >> 2) * 2;
        const float* onp = W.gla_onorm + 16 * vb0 + 4 * l4 + opaque0(); const f32x4 on0 = *(const f32x4*)onp, on1 = *(const f32x4*)(onp + 16);
        int it = valid_from(F.vcu); v4u w0, w1, wq, wk, wv; f32x4 s0, s1; v2u g0, g1;
        if (it < N) gla_c_issue(F, it, w0, w1, wq, wk, wv, s0, s1, g0, g1);
        while (it < N) { const int nx = valid_from(it + F.G); gla_c_item(F, W, it, nx, N, w0, w1, wq, wk, wv, s0, s1, g0, g1, on0, on1); it = nx; }
    }
    if (!(M3_SWAP && (F.vcu & 1))) rwkv_finish(F, W, need_ctx ? M_ALL : M_LAT);
}
__device__ __forceinline__ void ctx_gemm_n1024(Frame& F, const bf16* A  , const bf16* Wt, bf16* Y  , int K) {
    using namespace rwc;
    LAS unsigned char* L = F.lds + RING_OFF;
    const int l15 = F.lane & 15, l4 = F.lane >> 4, w = F.wave, nbk = w >> 1, mb0 = (w & 1) * 2;
    const int srow = F.tid >> 3, sch = F.tid & 7;
    const int nk = K >> 8;
    for (int tile = F.vcu; tile < 32 * 16; tile += F.G) {
        const int tm = tile >> 4, tn = tile & 15;
        const bf16* ap = A + (size_t)(tm * 64 + srow) * K + sch * 8; const bf16* bp = Wt + (size_t)(tn * 64 + srow) * K + sch * 8;
        f32x4 acc[2]; acc[0] = (f32x4){0.f, 0.f, 0.f, 0.f}; acc[1] = acc[0];
        v4u r0[8], r1[8];
#define CG_LOAD(R, s_) do { _Pragma("unroll") for (int q = 0; q < 4; ++q) { R[q] = *(const v4u*)(ap + (s_) * 256 + q * 64); R[4 + q] = *(const v4u*)(bp + (s_) * 256 + q * 64); } } while (0)
#define CG_STORE(R) do { _Pragma("unroll") for (int q = 0; q < 8; ++q) *(LAS v4u*)(L + q * MSZ + srow * ROWB + sch * 16) = R[q]; } while (0)
        CG_LOAD(r0, 0); if (nk > 1) CG_LOAD(r1, 1);
        for (int s = 0; s < nk; ++s) {
            if ((s & 1) == 0) { CG_STORE(r0); if (s + 2 < nk) CG_LOAD(r0, s + 2); } else { CG_STORE(r1); if (s + 2 < nk) CG_LOAD(r1, s + 2); }
            __syncthreads();
#pragma unroll
            for (int q = 0; q < 4; ++q) mmp(acc, L + (4 + q) * MSZ + (16 * nbk + l15) * ROWB + 16 * l4, L + q * MSZ + (16 * mb0 + l15) * ROWB + 16 * l4);
            __syncthreads();
        }
#undef CG_LOAD
#undef CG_STORE
#pragma unroll
        for (int j = 0; j < 2; ++j) { v2u o; o.x = cvtpk(acc[j][0], acc[j][1]); o.y = cvtpk(acc[j][2], acc[j][3]);
            *(v2u*)(Y + (size_t)(tm * 64 + 16 * (mb0 + j) + l15) * 1024 + tn * 64 + 16 * nbk + 4 * l4) = o; }
    }
}
#ifndef MK_PER_PHASE
#define MK_PER_PHASE 0
#endif
#ifndef GEMM_REV
#define GEMM_REV 1
#endif
constexpr int NPH_LAYER = 12, NPHASES = 2 + NLAYER * NPH_LAYER;
#ifndef MK_PHASE_MASK
#define MK_PHASE_MASK 0x3fff
#endif
#define PH_EN(k) (((MK_PHASE_MASK) >> (k)) & 1)
#ifndef MK_REPEAT_MASK
#define MK_REPEAT_MASK 0
#endif
#ifndef MK_REP_L0ONLY
#define MK_REP_L0ONLY 0
#endif
#define NREP(k) (((((MK_REPEAT_MASK) >> (k)) & 1) && (!(MK_REP_L0ONLY) || l == 0)) ? 2 : 1)
struct Args { const float* in[28]; float* out; unsigned char* ws; int ph_lo, ph_hi; };
__global__ void __launch_bounds__(NTHREADS, 2) dit_fwd(Args args) {
    extern __shared__ __attribute__((aligned(16))) unsigned char lds[];
    Frame F;
    F.lds = (LAS unsigned char*)lds;
    F.MISC = (volatile LAS unsigned*)(F.lds + MISC_OFF);
    F.tid = threadIdx.x; F.lane = F.tid & 63; F.wave = __builtin_amdgcn_readfirstlane(F.tid >> 6);
    F.G = gridDim.x; { const int bx = blockIdx.x; F.vcu = (F.G % 8 == 0) ? (bx % 8) * (F.G / 8) + bx / 8 : bx; }
    F.ws = args.ws; F.out = args.out; F.ctl = (gu32*)(args.ws + WS_CTL);
#pragma unroll
    for (int i = 0; i < 28; ++i) F.in[i] = args.in[i];
    for (int u = F.tid; u < (LDS_BYTES - LDSCTL_OFF) / 4; u += NTHREADS) ((LAS unsigned*)(F.lds + LDSCTL_OFF))[u] = 0u;
    __syncthreads();
#if MK_PER_PHASE
#define GRID_BAR() do { } while (0)
#else
    XcdBarrier bar = xcd_barrier_post((unsigned*)(F.ctl + CW_BAR), F.MISC + 8);
#define GRID_BAR() xcd_barrier(bar)
#endif
    const int lo = args.ph_lo, hi = args.ph_hi;
#define IN(k) (lo <= (k) && (k) < hi)
#define SEAM(k) do { if (IN(k) && IN((k) + 1)) GRID_BAR(); } while (0)
#define RESEED() do { int t_; asm volatile("v_mov_b32 %0, %1" : "=v"(t_) : "v"(threadIdx.x)); F.tid = t_; F.lane = t_ & 63; F.wave = __builtin_amdgcn_readfirstlane(t_ >> 6); \
        int b_; asm volatile("s_mov_b32 %0, %1" : "=s"(b_) : "s"(blockIdx.x)); F.vcu = (F.G % 8 == 0) ? (b_ % 8) * (F.G / 8) + b_ / 8 : b_; F.bid = b_; } while (0)
    bf16* const H = (bf16*)(F.ws + WS_HO); bf16* const Y = (bf16*)(F.ws + WS_Y); bf16* const U = (bf16*)(F.ws + WS_UP);
    bf16* const XB = (bf16*)F.out; bf16* const XB2 = (bf16*)(F.ws + WS_KC);
    float* const XC = (float*)(F.ws + WS_XC); const float* const MODV = (const float*)(F.ws + WS_MODV);
    LAS unsigned char* const ring = F.lds + RING_OFF;

    if (PH_EN(12) && IN(0)) { RESEED(); p0_prologue<1>(F); } SEAM(0);
    if (IN(1)) for (int rep = 0, l = 0; rep < NREP(12); ++rep) { if (rep) GRID_BAR();
        if (F.vcu & 1) { if (PH_EN(12)) { RESEED(); p0_prologue<2>(F); } }
        if (PH_EN(13)) { RESEED();
            thin_phase<false, true>(F, nullptr, F.in[I_X], F.in[I_CTX], nullptr, nullptr, nullptr, nullptr, 0.f, F.in[I_NORMG], MODV + 0 * 1024, MODV + 1 * 1024, H, M_ALL); }
        if (!(F.vcu & 1)) { if (PH_EN(12)) { RESEED(); p0_prologue<2>(F); } }
    } SEAM(1);
#define TD_X(p_) (rep ? (void*)(F.ws + WS_UP) : (void*)(p_))
#define TD_C(p_) (rep ? (float*)(F.ws + WS_UP + 300 * MiB) : (p_))
#define TD_H(p_) (rep ? (bf16*)(F.ws + WS_UP + 160 * MiB) : (p_))
    for (int l = 0; l < NLAYER; ++l) {
        const int pb = 2 + l * NPH_LAYER;
        const bool need_ctx = l < NLAYER - 1;
        const float* ng = F.in[I_NORMG] + (size_t)l * 6 * DM; const float* mv = MODV + (size_t)l * 9 * 9216;
        const int m_post = need_ctx ? M_ALL : M_LAT;
        const bf16* W13 = (const bf16*)(F.ws + WS_W13) + (size_t)l * 2 * (2 * DFF) * DM; const bf16* W2 = (const bf16*)(F.ws + WS_W2) + (size_t)l * 2 * DM * DFF;
        const bf16* WIN = (const bf16*)(F.ws + WS_WIN) + (size_t)l * PW * DM; const bf16* WOUT = (const bf16*)(F.ws + WS_WOUT) + (size_t)l * DM * DM;
        if (PH_EN(0) && IN(pb + 0)) for (int rep = 0; rep < NREP(0); ++rep) { if (rep) GRID_BAR(); RESEED();
            pg8::Gemm g{H, W13, M_ALL, 2 * DFF, DM}; pg8::StaticOrder S; S.init(M_ALL, 2 * DFF, F.G, F.bid);
            pg8::EpiSwiglu E{U, DFF};
            pg8::gemm_phase<pg8::EpiSwiglu, pg8::StaticOrder, true, true>(ring, g, S, E);
        } SEAM(pb + 0);
        if (PH_EN(1) && IN(pb + 1)) for (int rep = 0; rep < NREP(1); ++rep) { if (rep) GRID_BAR(); RESEED();
            pg8::Gemm g{U, W2, M_LAT, DM, DFF}; pg8::StaticOrder S; S.init(M_LAT, DM, F.G, F.bid, GEMM_REV);
            pg8::EpiBf16<0> E{Y, DM, nullptr, 0, 0, 1.f};
            pg8::gemm_phase<pg8::EpiBf16<0>, pg8::StaticOrder, true, true>(ring, g, S, E);
            ctx_gemm_n1024(F, U + (size_t)M_LAT * DFF, W2, Y + (size_t)M_LAT * DM, DFF);
        } SEAM(pb + 1);
        if (PH_EN(2) && IN(pb + 2)) for (int rep = 0; rep < NREP(2); ++rep) { if (rep) GRID_BAR(); RESEED();
            if (l == 0) thin_phase<true, true, false, true>(F, Y, F.in[I_X], F.in[I_CTX], TD_X(XB), TD_C(XC), ng + 1 * DM, mv + 2 * 1024, 0.5f, ng + 2 * DM, mv + 3 * 1024, mv + 4 * 1024, TD_H(H), M_ALL);
            else thin_phase<true, true, true, true>(F, Y, XB, XC, TD_X(XB), TD_C(XC), ng + 1 * DM, mv + 2 * 1024, 0.5f, ng + 2 * DM, mv + 3 * 1024, mv + 4 * 1024, TD_H(H), M_ALL);
        } SEAM(pb + 2);
        if (PH_EN(3) && IN(pb + 3)) for (int rep = 0; rep < NREP(3); ++rep) { if (rep) GRID_BAR(); RESEED();
            pg8::Gemm g{H, WIN, M_ALL, PW, DM}; pg8::StaticOrder S; S.init(M_ALL, PW, F.G, F.bid);
            pg8::EpiBf16<0> E{U, 256, nullptr, 256, (size_t)M_ALL * 256, 1.f};
            pg8::gemm_phase<pg8::EpiBf16<0>, pg8::StaticOrder, true, true>(ring, g, S, E);
        } SEAM(pb + 3);
        if (PH_EN(4) && IN(pb + 4)) for (int rep = 0; rep < NREP(4); ++rep) { if (rep) GRID_BAR(); RESEED(); m1_prep(F, l, rep); } SEAM(pb + 4);
        if (PH_EN(5) && IN(pb + 5)) for (int rep = 0; rep < NREP(5); ++rep) { if (rep) GRID_BAR(); RESEED(); m2_queue(F, l, rep); } SEAM(pb + 5);
        if (PH_EN(6) && IN(pb + 6)) for (int rep = 0; rep < NREP(6); ++rep) { if (rep) GRID_BAR(); RESEED(); m3_finish(F, l); } SEAM(pb + 6);
        if (PH_EN(7) && IN(pb + 7)) for (int rep = 0; rep < NREP(7); ++rep) { if (rep) GRID_BAR(); RESEED();
            pg8::Gemm g{H, WOUT, M_LAT, DM, DM}; pg8::StaticOrder S; S.init(M_LAT, DM, F.G, F.bid);
            pg8::EpiBf16<0> E{Y, DM, nullptr, 0, 0, 1.f};
            pg8::gemm_phase<pg8::EpiBf16<0>, pg8::StaticOrder, true, true>(ring, g, S, E);
            if (need_ctx) ctx_gemm_n1024(F, H + (size_t)M_LAT * DM, WOUT, Y + (size_t)M_LAT * DM, DM);
        } SEAM(pb + 7);
        if (PH_EN(8) && IN(pb + 8)) for (int rep = 0; rep < NREP(8); ++rep) { if (rep) GRID_BAR(); RESEED();
            thin_phase<true, true, true, true>(F, Y, XB, XC, TD_X(need_ctx ? XB : XB2), TD_C(XC), ng + 3 * DM, mv + 5 * 1024, 1.0f, ng + 4 * DM, mv + 6 * 1024, mv + 7 * 1024, TD_H(H), m_post);
        } SEAM(pb + 8);
        if (PH_EN(9) && IN(pb + 9)) for (int rep = 0; rep < NREP(9); ++rep) { if (rep) GRID_BAR(); RESEED();
            pg8::Gemm g{H, W13 + (size_t)(2 * DFF) * DM, m_post, 2 * DFF, DM}; pg8::StaticOrder S; S.init(m_post, 2 * DFF, F.G, F.bid);
            pg8::EpiSwiglu E{U, DFF};
            pg8::gemm_phase<pg8::EpiSwiglu, pg8::StaticOrder, true, true>(ring, g, S, E);
        } SEAM(pb + 9);
        if (PH_EN(10) && IN(pb + 10)) for (int rep = 0; rep < NREP(10); ++rep) { if (rep) GRID_BAR(); RESEED();
            pg8::Gemm g{U, W2 + (size_t)DM * DFF, M_LAT, DM, DFF}; pg8::StaticOrder S; S.init(M_LAT, DM, F.G, F.bid, GEMM_REV);
            pg8::EpiBf16<0> E{Y, DM, nullptr, 0, 0, 1.f};
            pg8::gemm_phase<pg8::EpiBf16<0>, pg8::StaticOrder, true, true>(ring, g, S, E);
            if (need_ctx) ctx_gemm_n1024(F, U + (size_t)M_LAT * DFF, W2 + (size_t)DM * DFF, Y + (size_t)M_LAT * DM, DFF);
        } SEAM(pb + 10);
        if (PH_EN(11) && IN(pb + 11)) for (int rep = 0; rep < NREP(11); ++rep) { if (rep) GRID_BAR(); RESEED();
            if (need_ctx) thin_phase<true, true, true, true>(F, Y, XB, XC, TD_X(XB), TD_C(XC), ng + 5 * DM, mv + 8 * 1024, 0.5f, ng + 6 * DM, mv + 9 * 9216 + 0 * 1024, mv + 9 * 9216 + 1 * 1024, TD_H(H), m_post);
            else thin_phase<true, false, true, false>(F, Y, XB2, XC, TD_X(F.out), TD_C(XC), ng + 5 * DM, mv + 8 * 1024, 0.5f, nullptr, nullptr, nullptr, nullptr, m_post);
        } SEAM(pb + 11);
    }
#undef IN
#undef SEAM
}

extern "C" void kernel_launch(void* const* d_in, const int* in_sizes, int n_in, void* d_out, int out_size, void* d_ws, size_t ws_size, hipStream_t stream) {
    static int grid = 0;
    if (grid == 0) {
        if (n_in != 28 || in_sizes[0] != M_LAT * DM || out_size != M_LAT * DM || ws_size < WS_END) {
            fprintf(stderr, "kernel_launch: unexpected shapes: n_in %d in0 %d out %d ws %zu (need >= %zu); nothing launched\n", n_in, n_in > 0 ? in_sizes[0] : -1, out_size, ws_size, (size_t)WS_END); grid = -1; return; }
        int dev = 0, cus = 0, per_cu = 0;
        if (hipGetDevice(&dev) != hipSuccess || hipDeviceGetAttribute(&cus, hipDeviceAttributeMultiprocessorCount, dev) != hipSuccess) { fprintf(stderr, "kernel_launch: device query failed\n"); grid = -1; return; }
        if (hipFuncSetAttribute((const void*)dit_fwd, hipFuncAttributeMaxDynamicSharedMemorySize, LDS_BYTES) != hipSuccess) { fprintf(stderr, "kernel_launch: hipFuncSetAttribute failed\n"); grid = -1; return; }
        if (hipOccupancyMaxActiveBlocksPerMultiprocessor(&per_cu, (const void*)dit_fwd, NTHREADS, LDS_BYTES) != hipSuccess || per_cu < 1)
            fprintf(stderr, "kernel_launch: note: occupancy query reports %d workgroups per CU\n", per_cu);
        (void)hipGetLastError();
        grid = cus;
    }
    if (grid < 0) return;
    if (hipMemsetAsync((char*)d_ws + WS_CTL, 0, CTL_ZERO_BYTES, stream) != hipSuccess) { fprintf(stderr, "kernel_launch: memset failed\n"); return; }
    Args a{};
    for (int i = 0; i < 28; ++i) a.in[i] = (const float*)d_in[i];
    a.out = (float*)d_out; a.ws = (unsigned char*)d_ws;
#if MK_PER_PHASE
    for (int p = 0; p < NPHASES; ++p) { a.ph_lo = p; a.ph_hi = p + 1; hipLaunchKernelGGL(dit_fwd, dim3(grid), dim3(NTHREADS), LDS_BYTES, stream, a); }
#else
    a.ph_lo = 0; a.ph_hi = NPHASES;
    hipLaunchKernelGGL(dit_fwd, dim3(grid), dim3(NTHREADS), LDS_BYTES, stream, a);
#endif
    const hipError_t le = hipPeekAtLastError();
    if (le != hipSuccess) fprintf(stderr, "kernel_launch: launch failed: %s\n", hipGetErrorName(le));
}
```
